# Optimizing an MI355X kernel written in HIP

```python
import jax, jax.numpy as jnp
from jax import lax
import numpy as np

D_MODEL = 1024
BATCH = 16
SEQ = 2048
DEPTH = 2

N_A_LAYERS = DEPTH // 2
N_B_LAYERS = DEPTH - N_A_LAYERS
LRU_WIDTH = 1344
LRU_BLOCKS = 8
LRU_BLOCK_DIM = LRU_WIDTH // LRU_BLOCKS
LRU_CONV_WIDTH = 4
RG_C = 8.0
N_HEADS = 16
N_KV_HEADS = 2
HEAD_DIM = 64
GROUP = N_HEADS // N_KV_HEADS
ROPE_DIM = HEAD_DIM // 4
ROPE_THETA = 500000.0
WINDOW = 128
BLOCK = 128
D_FF = 3 * D_MODEL
FFN_CONV_WIDTH = 3
EPS = 1e-6
MAX_POS_OFFSET = 4096
MASK_VALUE = -1e30

kernel_name = "yoco_hawk_swa_sink_convffn_trunk"


def rms_norm(x, g):
    xf = x.astype(jnp.float32)
    var = jnp.mean(xf * xf, axis=-1, keepdims=True)
    return (xf * lax.rsqrt(var + EPS) * g.astype(jnp.float32)).astype(x.dtype)


def causal_depthwise_conv(x, w, b):
    k_w = w.shape[0]
    s = x.shape[1]
    xp = jnp.pad(x, ((0, 0), (k_w - 1, 0), (0, 0)))
    out = b
    for k in range(k_w):
        out = out + xp[:, k:k + s] * w[k]
    return out


def rope_partial(x, positions):
    half = ROPE_DIM // 2
    inv_freq = ROPE_THETA ** (-jnp.arange(0, ROPE_DIM, 2, dtype=jnp.float32) / ROPE_DIM)
    ang = positions.astype(jnp.float32)[..., None] * inv_freq
    cos = jnp.cos(ang)[:, :, None, :]
    sin = jnp.sin(ang)[:, :, None, :]
    xf = x.astype(jnp.float32)
    x1 = xf[..., :half]
    x2 = xf[..., half:ROPE_DIM]
    rot = jnp.concatenate([x1 * cos - x2 * sin, x2 * cos + x1 * sin, xf[..., ROPE_DIM:]], axis=-1)
    return rot.astype(x.dtype)


def _lin_combine(e1, e2):
    a1, b1 = e1
    a2, b2 = e2
    return a1 * a2, a2 * b1 + b2


def rg_lru(xr, w_rg, b_rg, w_ig, b_ig, lam):
    bsz, s, w = xr.shape
    xb = xr.reshape(bsz, s, LRU_BLOCKS, LRU_BLOCK_DIM)
    r = jax.nn.sigmoid(jnp.einsum('bshi,hij->bshj', xb, w_rg).reshape(bsz, s, w).astype(jnp.float32) + b_rg.astype(jnp.float32))
    i = jax.nn.sigmoid(jnp.einsum('bshi,hij->bshj', xb, w_ig).reshape(bsz, s, w).astype(jnp.float32) + b_ig.astype(jnp.float32))
    log_a = -RG_C * r * jax.nn.softplus(-lam.astype(jnp.float32))
    a = jnp.exp(log_a)
    u = jnp.sqrt(-jnp.expm1(2.0 * log_a)) * i * xr.astype(jnp.float32)
    _, h = lax.associative_scan(_lin_combine, (a, u), axis=1)
    return h.astype(xr.dtype)


def recurrent_block(hn, w_gate, w_in, conv_w, conv_b, w_rg, b_rg, w_ig, b_ig, lam, w_out):
    gate = jax.nn.gelu(hn @ w_gate)
    xr = causal_depthwise_conv(hn @ w_in, conv_w, conv_b)
    y = rg_lru(xr, w_rg, b_rg, w_ig, b_ig, lam)
    return (gate * y) @ w_out


def conv_ffn(hn, w_up, conv_w, conv_b, w_down):
    up = causal_depthwise_conv(hn @ w_up, conv_w, conv_b)
    gate, val = jnp.split(up, 2, axis=-1)
    return (jax.nn.gelu(gate) * val) @ w_down


def shared_kv(h, kv_norm, w_k, w_v, k_norm, positions):
    bsz, s, _ = h.shape
    hn = rms_norm(h, kv_norm)
    k = (hn @ w_k).reshape(bsz, s, N_KV_HEADS, HEAD_DIM)
    k = rope_partial(rms_norm(k, k_norm), positions)
    v = (hn @ w_v).reshape(bsz, s, N_KV_HEADS, HEAD_DIM)
    return k, v


def banded_sink_attention(q, k, v, sinks):
    bsz, s = q.shape[0], q.shape[1]
    nb = s // BLOCK
    qb = q.reshape(bsz, nb, BLOCK, N_KV_HEADS, GROUP, HEAD_DIM)

    def band(t):
        tb = t.reshape(bsz, nb, BLOCK, N_KV_HEADS, HEAD_DIM)
        prev = jnp.concatenate([jnp.zeros_like(tb[:, :1]), tb[:, :-1]], axis=1)
        return jnp.concatenate([prev, tb], axis=2)

    kband = band(k)
    vband = band(v)
    scale = HEAD_DIM ** -0.5
    scores = jnp.einsum('bnqhgd,bnkhd->bnhgqk', qb, kband).astype(jnp.float32) * scale
    qpos = jnp.arange(BLOCK)
    kpos = jnp.arange(2 * BLOCK) - BLOCK
    diff = qpos[:, None] - kpos[None, :]
    in_band = (diff >= 0) & (diff < WINDOW)
    valid_key = (jnp.arange(nb)[:, None] * BLOCK + kpos[None, :]) >= 0
    mask = in_band[None, :, :] & valid_key[:, None, :]
    scores = jnp.where(mask[None, :, None, None], scores, MASK_VALUE)
    sink = sinks.astype(jnp.float32).reshape(1, 1, N_KV_HEADS, GROUP, 1, 1)
    m = jnp.maximum(jnp.max(scores, axis=-1, keepdims=True), sink)
    p = jnp.exp(scores - m)
    denom = jnp.sum(p, axis=-1, keepdims=True) + jnp.exp(sink - m)
    probs = (p / denom).astype(v.dtype)
    o = jnp.einsum('bnhgqk,bnkhd->bnqhgd', probs, vband)
    return o.reshape(bsz, s, N_HEADS * HEAD_DIM)


def swa_layer(hn, k, v, positions, w_q, q_norm, sinks, w_o):
    bsz, s, _ = hn.shape
    q = (hn @ w_q).reshape(bsz, s, N_HEADS, HEAD_DIM)
    q = rope_partial(rms_norm(q, q_norm), positions)
    return banded_sink_attention(q, k, v, sinks) @ w_o


def setup_inputs(seed: int = 0) -> dict:
    key = jax.random.key(seed)
    ks = jax.random.split(key, 32)
    f32 = jnp.float32

    def nrm(k, shape, fan_in):
        return jax.random.normal(k, shape, f32) * (fan_in ** -0.5)

    def gain(k, shape):
        return 1.0 + 0.05 * jax.random.normal(k, shape, f32)

    def bias(k, shape):
        return 0.02 * jax.random.normal(k, shape, f32)

    x = jax.random.normal(ks[0], (BATCH, SEQ, D_MODEL), f32)
    offsets = jax.random.randint(ks[1], (BATCH, 1), 0, MAX_POS_OFFSET, dtype=jnp.int32)
    positions = (offsets + jnp.arange(SEQ, dtype=jnp.int32)[None, :]).astype(jnp.int32)

    u = jax.random.uniform(ks[2], (N_A_LAYERS, LRU_WIDTH), f32, minval=0.9, maxval=0.999)
    s_a = u ** (1.0 / RG_C)
    lam = jnp.log(s_a) - jnp.log1p(-s_a)

    qkv_w = N_HEADS * HEAD_DIM
    kv_w = N_KV_HEADS * HEAD_DIM
    return {
        "x": x,
        "positions": positions,
        "a_norm": gain(ks[3], (N_A_LAYERS, D_MODEL)),
        "a_w_gate": nrm(ks[4], (N_A_LAYERS, D_MODEL, LRU_WIDTH), D_MODEL),
        "a_w_in": nrm(ks[5], (N_A_LAYERS, D_MODEL, LRU_WIDTH), D_MODEL),
        "a_conv_w": nrm(ks[6], (N_A_LAYERS, LRU_CONV_WIDTH, LRU_WIDTH), LRU_CONV_WIDTH),
        "a_conv_b": bias(ks[7], (N_A_LAYERS, LRU_WIDTH)),
        "a_w_rg": nrm(ks[8], (N_A_LAYERS, LRU_BLOCKS, LRU_BLOCK_DIM, LRU_BLOCK_DIM), LRU_BLOCK_DIM),
        "a_b_rg": bias(ks[9], (N_A_LAYERS, LRU_WIDTH)),
        "a_w_ig": nrm(ks[10], (N_A_LAYERS, LRU_BLOCKS, LRU_BLOCK_DIM, LRU_BLOCK_DIM), LRU_BLOCK_DIM),
        "a_b_ig": bias(ks[11], (N_A_LAYERS, LRU_WIDTH)),
        "a_lam": lam,
        "a_w_out": nrm(ks[12], (N_A_LAYERS, LRU_WIDTH, D_MODEL), LRU_WIDTH),
        "kv_norm": gain(ks[13], (D_MODEL,)),
        "w_k": nrm(ks[14], (D_MODEL, kv_w), D_MODEL),
        "w_v": nrm(ks[15], (D_MODEL, kv_w), D_MODEL),
        "k_norm": gain(ks[16], (HEAD_DIM,)),
        "b_norm": gain(ks[17], (N_B_LAYERS, D_MODEL)),
        "b_w_q": nrm(ks[18], (N_B_LAYERS, D_MODEL, qkv_w), D_MODEL),
        "q_norm": gain(ks[19], (N_B_LAYERS, HEAD_DIM)),
        "sinks": 0.5 * jax.random.normal(ks[20], (N_B_LAYERS, N_HEADS), f32),
        "b_w_o": nrm(ks[21], (N_B_LAYERS, qkv_w, D_MODEL), qkv_w),
        "f_norm": gain(ks[22], (DEPTH, D_MODEL)),
        "f_w_up": nrm(ks[23], (DEPTH, D_MODEL, 2 * D_FF), D_MODEL),
        "f_conv_w": nrm(ks[24], (DEPTH, FFN_CONV_WIDTH, 2 * D_FF), FFN_CONV_WIDTH),
        "f_conv_b": bias(ks[25], (DEPTH, 2 * D_FF)),
        "f_w_down": nrm(ks[26], (DEPTH, D_FF, D_MODEL), D_FF),
    }


def reference(x, positions, a_norm, a_w_gate, a_w_in, a_conv_w, a_conv_b, a_w_rg, a_b_rg,
              a_w_ig, a_b_ig, a_lam, a_w_out, kv_norm, w_k, w_v, k_norm, b_norm, b_w_q,
              q_norm, sinks, b_w_o, f_norm, f_w_up, f_conv_w, f_conv_b, f_w_down):
    h = x
    k_sh = None
    v_sh = None
    for layer in range(DEPTH):
        if layer < N_A_LAYERS:
            i = layer
            h = h + recurrent_block(rms_norm(h, a_norm[i]), a_w_gate[i], a_w_in[i], a_conv_w[i],
                                    a_conv_b[i], a_w_rg[i], a_b_rg[i], a_w_ig[i], a_b_ig[i],
                                    a_lam[i], a_w_out[i])
        else:
            j = layer - N_A_LAYERS
            h = h + swa_layer(rms_norm(h, b_norm[j]), k_sh, v_sh, positions, b_w_q[j],
                              q_norm[j], sinks[j], b_w_o[j])
        h = h + conv_ffn(rms_norm(h, f_norm[layer]), f_w_up[layer], f_conv_w[layer],
                         f_conv_b[layer], f_w_down[layer])
        if layer == N_A_LAYERS - 1:
            k_sh, v_sh = shared_kv(h, kv_norm, w_k, w_v, k_norm, positions)
    return h
```

```cpp
#include <hip/hip_runtime.h>
#include <cstdio>
#include <cstdint>
namespace pg8 {
#define PG8_LAS __attribute__((address_space(3)))
typedef unsigned short bf16_t;
typedef short bf16x8 __attribute__((ext_vector_type(8)));
typedef float f32x4 __attribute__((ext_vector_type(4)));
typedef unsigned u32x4 __attribute__((ext_vector_type(4)));
constexpr int BM = 256, BK = 64, HALF = 128, HTB = HALF * BK * 2  , STAGE_BYTES = 8 * HTB, NXCD = 8, WGM = 8;

__host__ __device__ __forceinline__ int lds_byte(int r, int c) { const int st = (r >> 4) * 2 + (c >> 5), rr = r & 15, cc = c & 31, ob = rr * 64 + cc * 2; return st * 1024 + (ob ^ (((ob >> 9) & 1) << 5)); }
__host__ __device__ __forceinline__ void stage_rc(int b, int& R, int& C) { const int st = b / 1024, sb = b % 1024, swz = sb ^ (((sb >> 9) & 1) << 5); R = (st >> 1) * 16 + swz / 64; C = (st & 1) * 32 + (swz % 64) / 2; }
__host__ __device__ __forceinline__ int perm32(int rho) { const int n = rho >> 4, i = rho & 15; return 8 * (i >> 2) + 4 * n + (i & 3); }

struct Unit { int pm, pn; };
struct Gemm { const bf16_t* A; const bf16_t* Bt; int M, N, K; };

struct StaticOrder {
    int nM, nN, nwg, G, c;
    __host__ __device__ void init(int M, int N, int G_, int c_) { nM = M / BM; nN = N / BM; nwg = nM * nN; G = G_; c = c_; }
    __host__ __device__ bool next(int i, Unit& u) const {
        const long L = (long)i * G + c; if (L >= nwg) return false;
        int wgid = (int)L; { const int q = nwg / NXCD, r = nwg % NXCD, xcd = wgid % NXCD, off = wgid / NXCD; wgid = (xcd < r ? xcd * (q + 1) : r * (q + 1) + (xcd - r) * q) + off; }
        const int nig = WGM * nN, gid = wgid / nig, fm = gid * WGM, gsz = (nM - fm) < WGM ? (nM - fm) : WGM;
        u.pm = fm + ((wgid % nig) % gsz); u.pn = (wgid % nig) / gsz; return true;
    }
    __device__ __forceinline__ void a_ready(const Unit&) const {}
    __device__ __forceinline__ void done(const Unit&) const {}
};

__device__ __forceinline__ unsigned cvt_pk_bf16(float lo, float hi) { unsigned r; asm volatile("v_cvt_pk_bf16_f32 %0, %1, %2" : "=v"(r) : "v"(lo), "v"(hi)); return r; }
typedef float f32x2 __attribute__((ext_vector_type(2)));
__device__ __forceinline__ f32x2 gelu_pk(f32x2 v) {
    const f32x2 av = __builtin_elementwise_abs(v), d = av * 0.2316418882f + 1.0f;
    f32x2 t; t.x = __builtin_amdgcn_rcpf(d.x); t.y = __builtin_amdgcn_rcpf(d.y);
    f32x2 q = t * 0.5307027145f + (-0.7265760135f); q = q * t + 0.7107068705f; q = q * t + (-0.142248368f); q = q * t + 0.127414796f; q = q * t;
    const f32x2 s = (v * v) * (-0.72134752044f);
    f32x2 e; e.x = __builtin_amdgcn_exp2f(s.x); e.y = __builtin_amdgcn_exp2f(s.y);
    const f32x2 m = v * (q * e), r = v - m;
    f32x2 o; o.x = v.x < 0.f ? m.x : r.x; o.y = v.y < 0.f ? m.y : r.y; return o;
}

template <int ACT  > struct EpiBf16 {
    static constexpr bool PERM = true, AFTER_DRAIN = false; static_assert(ACT == 0 || ACT == 1, "EpiBf16: ACT is 0 (none) or 1 (gelu_pk)");
    bf16_t* O; int ldc; const float* bias; int split_cols; size_t split_stride; float scale0;
    __device__ __forceinline__ void operator()(const f32x4 (&acc)[2][2][4][2], const Unit& u, int wr, int wc, int fr, int fq) const {
        const int row0 = u.pm * BM + wr * 64 + fr; int colt = u.pn * BM; bf16_t* base = O;
        float sc = 1.f; if (split_cols) { const int t = colt / split_cols; base += (size_t)t * split_stride; colt -= t * split_cols; if (t == 0) sc = scale0; }
        const int col0 = colt + wc * 32 + 8 * fq, bcol0 = u.pn * BM + wc * 32 + 8 * fq;
        f32x4 bv[2][2];
#pragma unroll
        for (int bj = 0; bj < 2; ++bj)
#pragma unroll
            for (int n = 0; n < 2; ++n) bv[bj][n] = bias ? *(const f32x4*)(bias + bcol0 + bj * HALF + 4 * n) : (f32x4){0.f, 0.f, 0.f, 0.f};
#pragma unroll
        for (int ai = 0; ai < 2; ++ai)
#pragma unroll
            for (int m = 0; m < 4; ++m) { bf16_t* rowp = base + (size_t)(row0 + ai * HALF + m * 16) * ldc + col0;
#pragma unroll
                for (int bj = 0; bj < 2; ++bj) { f32x4 v0 = acc[ai][bj][m][0] + bv[bj][0], v1 = acc[ai][bj][m][1] + bv[bj][1];
                    if (ACT == 1) { f32x2 a = gelu_pk((f32x2){v0[0], v0[1]}), b = gelu_pk((f32x2){v0[2], v0[3]}), c = gelu_pk((f32x2){v1[0], v1[1]}), d = gelu_pk((f32x2){v1[2], v1[3]});
                        v0 = (f32x4){a.x, a.y, b.x, b.y}; v1 = (f32x4){c.x, c.y, d.x, d.y}; }
                    v0 = v0 * sc; v1 = v1 * sc; u32x4 w; w.x = cvt_pk_bf16(v0[0], v0[1]); w.y = cvt_pk_bf16(v0[2], v0[3]); w.z = cvt_pk_bf16(v1[0], v1[1]); w.w = cvt_pk_bf16(v1[2], v1[3]);
                    *(u32x4*)(rowp + bj * HALF) = w; } }
    }
};
template <class Epi, class Sched, bool ALIGN_EPI = false, bool SP2 = false>
__device__ __forceinline__ void gemm_phase(PG8_LAS unsigned char* lds, const Gemm g, const Sched& S, const Epi& E) {
    const int tid = threadIdx.x, wid = __builtin_amdgcn_readfirstlane(tid >> 6), lane = tid & 63, wr = wid >> 2, wc = wid & 3, fr = lane & 15, fq = lane >> 4;
    const int K = g.K, nt = K / BK;
    unsigned voffA[2], voffB[2];
#pragma unroll
    for (int i = 0; i < 2; ++i) { int R, C; stage_rc(tid * 16 + i * 8192, R, C); const int Rb = Epi::PERM ? ((R & ~31) + perm32(R & 31)) : R;
        voffA[i] = (unsigned)(R * K + C) * 2u; voffB[i] = (unsigned)(Rb * K + C) * 2u; }
    const size_t kstep = (size_t)(BK * 2);
    const size_t hstep = (size_t)HALF * K * 2;
    const size_t tstep = 2 * hstep;
    const unsigned ldsw = (unsigned)wid * 1024u;
    const int aoff = lds_byte(wr * 64 + fr, fq * 8), boff = lds_byte(wc * 32 + fr, fq * 8);
#define PG8_SA(b, h) (((b) * 2 + (h)) * HTB)
#define PG8_SB(b, h) ((4 + (b) * 2 + (h)) * HTB)
#define PG8_STAGE(bufoff, gbase, voff) do { _Pragma("unroll") for (int _i = 0; _i < 2; ++_i) \
        __builtin_amdgcn_global_load_lds((const unsigned*)((const char*)(gbase) + (voff)[_i]), (PG8_LAS unsigned*)(lds + (bufoff) + ldsw + _i * 8192), 16, 0, 0); } while (0)
#define PG8_LDA(dst, b, h) do { _Pragma("unroll") for (int m = 0; m < 4; ++m) _Pragma("unroll") for (int k = 0; k < 2; ++k) dst[m][k] = *(const PG8_LAS bf16x8*)(lds + PG8_SA(b, h) + aoff + m * 2048 + k * 1024); } while (0)
#define PG8_LDB(dst, b, h) do { _Pragma("unroll") for (int n = 0; n < 2; ++n) _Pragma("unroll") for (int k = 0; k < 2; ++k) dst[n][k] = *(const PG8_LAS bf16x8*)(lds + PG8_SB(b, h) + boff + n * 2048 + k * 1024); } while (0)
#define PG8_MMA(ai, bj, At, Bt) do { __builtin_amdgcn_s_setprio(1); _Pragma("unroll") for (int m = 0; m < 4; ++m) _Pragma("unroll") for (int n = 0; n < 2; ++n) _Pragma("unroll") for (int k = 0; k < 2; ++k) \
        acc[ai][bj][m][n] = __builtin_amdgcn_mfma_f32_16x16x32_bf16(Bt[n][k], At[m][k], acc[ai][bj][m][n], 0, 0, 0); __builtin_amdgcn_s_setprio(0); } while (0)
#define PG8_WAIT_V(n) asm volatile("s_waitcnt vmcnt(" #n ")" ::: "memory")
#define PG8_WAIT_L(n) asm volatile("s_waitcnt lgkmcnt(" #n ")" ::: "memory")
#define PG8_BAR __builtin_amdgcn_s_barrier()
#define PG8_SCHED __builtin_amdgcn_sched_barrier(0)
    Unit cur, nxt; int ui = 0;
    if (!S.next(0, cur)) return;
    f32x4 acc[2][2][4][2];
#pragma unroll
    for (int a = 0; a < 2; ++a)
#pragma unroll
        for (int b = 0; b < 2; ++b)
#pragma unroll
            for (int m = 0; m < 4; ++m)
#pragma unroll
                for (int n = 0; n < 2; ++n) acc[a][b][m][n] = (f32x4){0.f, 0.f, 0.f, 0.f};
    bf16x8 At[4][2], B0[2][2], B1[2][2];
    const char* cA = (const char*)g.A + (size_t)cur.pm * tstep; const char* cB = (const char*)g.Bt + (size_t)cur.pn * tstep;
    S.a_ready(cur);
    if constexpr (SP2) {
        PG8_STAGE(PG8_SB(0, 0), cB, voffB); PG8_STAGE(PG8_SB(0, 1), cB + hstep, voffB); PG8_STAGE(PG8_SA(0, 0), cA, voffA); PG8_STAGE(PG8_SA(0, 1), cA + hstep, voffA);
        if (wr == 1) PG8_BAR;
        PG8_WAIT_V(2); PG8_BAR;
        PG8_STAGE(PG8_SB(1, 0), cB + kstep, voffB); PG8_STAGE(PG8_SA(1, 0), cA + kstep, voffA); PG8_STAGE(PG8_SB(1, 1), cB + hstep + kstep, voffB);
        PG8_WAIT_V(6); PG8_BAR;
    } else {
        PG8_STAGE(PG8_SB(0, 0), cB, voffB); PG8_STAGE(PG8_SA(0, 0), cA, voffA); PG8_STAGE(PG8_SB(0, 1), cB + hstep, voffB); PG8_STAGE(PG8_SA(0, 1), cA + hstep, voffA);
        if (wr == 1) PG8_BAR;
        PG8_WAIT_V(4); PG8_BAR;
        PG8_STAGE(PG8_SB(1, 0), cB + kstep, voffB); PG8_STAGE(PG8_SA(1, 0), cA + kstep, voffA); PG8_STAGE(PG8_SB(1, 1), cB + hstep + kstep, voffB);
        PG8_WAIT_V(6); PG8_BAR;
    }
    for (;;) {
        const bool has_next = S.next(ui + 1, nxt);
        const char* nA = has_next ? (const char*)g.A + (size_t)nxt.pm * tstep : cA; const char* nB = has_next ? (const char*)g.Bt + (size_t)nxt.pn * tstep : cB;
        for (int t = 0; t < nt; t += 2) {
            const bool last = (t == nt - 2);
            const char* a1 = cA + (size_t)(t + 1) * kstep;
            const char* a2 = last ? nA : cA + (size_t)(t + 2) * kstep; const char* b2 = last ? nB : cB + (size_t)(t + 2) * kstep;
            const char* a3 = a2 + kstep; const char* b3 = b2 + kstep;
            if (last && has_next) S.a_ready(nxt);
            if constexpr (SP2) {
            PG8_LDB(B0, 0, 0); PG8_LDB(B1, 0, 1); PG8_SCHED; PG8_LDA(At, 0, 0); PG8_STAGE(PG8_SA(1, 1), a1 + hstep, voffA);
            PG8_WAIT_V(8); PG8_WAIT_L(0); PG8_BAR; PG8_MMA(0, 0, At, B0); PG8_MMA(0, 1, At, B1); PG8_BAR; PG8_SCHED;
            PG8_LDA(At, 0, 1); PG8_STAGE(PG8_SB(0, 0), b2, voffB); PG8_STAGE(PG8_SB(0, 1), b2 + hstep, voffB); PG8_STAGE(PG8_SA(0, 0), a2, voffA);
            PG8_WAIT_V(8); PG8_WAIT_L(0); PG8_BAR; PG8_MMA(1, 0, At, B0); PG8_MMA(1, 1, At, B1); PG8_BAR; PG8_SCHED;
            PG8_LDB(B0, 1, 0); PG8_LDB(B1, 1, 1); PG8_SCHED; PG8_LDA(At, 1, 0); PG8_STAGE(PG8_SA(0, 1), a2 + hstep, voffA);
            PG8_WAIT_V(8); PG8_WAIT_L(0); PG8_BAR; PG8_MMA(0, 0, At, B0); PG8_MMA(0, 1, At, B1); PG8_BAR; PG8_SCHED;
            PG8_LDA(At, 1, 1); PG8_STAGE(PG8_SB(1, 0), b3, voffB); PG8_STAGE(PG8_SB(1, 1), b3 + hstep, voffB); PG8_STAGE(PG8_SA(1, 0), a3, voffA);
            PG8_WAIT_V(8); PG8_WAIT_L(0); PG8_BAR; PG8_MMA(1, 0, At, B0); PG8_MMA(1, 1, At, B1); PG8_BAR; PG8_SCHED;
            } else {
            PG8_LDB(B0, 0, 0); PG8_SCHED; PG8_LDA(At, 0, 0); PG8_STAGE(PG8_SA(1, 1), a1 + hstep, voffA);
            PG8_WAIT_L(8); PG8_BAR; PG8_WAIT_L(0); PG8_MMA(0, 0, At, B0); PG8_BAR; PG8_SCHED;
            PG8_LDB(B1, 0, 1); PG8_STAGE(PG8_SB(0, 0), b2, voffB);
            PG8_BAR; PG8_WAIT_L(0); PG8_MMA(0, 1, At, B1); PG8_BAR;
            PG8_LDA(At, 0, 1); PG8_STAGE(PG8_SA(0, 0), a2, voffA);
            PG8_BAR; PG8_WAIT_L(0); PG8_MMA(1, 0, At, B0); PG8_BAR; PG8_SCHED;
            PG8_STAGE(PG8_SB(0, 1), b2 + hstep, voffB);
            PG8_WAIT_V(6); PG8_BAR; PG8_MMA(1, 1, At, B1); PG8_BAR;
            PG8_LDB(B0, 1, 0); PG8_SCHED; PG8_LDA(At, 1, 0); PG8_STAGE(PG8_SA(0, 1), a2 + hstep, voffA);
            PG8_WAIT_L(8); PG8_BAR; PG8_WAIT_L(0); PG8_MMA(0, 0, At, B0); PG8_BAR; PG8_SCHED;
            PG8_LDB(B1, 1, 1); PG8_STAGE(PG8_SB(1, 0), b3, voffB);
            PG8_BAR; PG8_WAIT_L(0); PG8_MMA(0, 1, At, B1); PG8_BAR;
            PG8_LDA(At, 1, 1); PG8_STAGE(PG8_SA(1, 0), a3, voffA);
            PG8_BAR; PG8_WAIT_L(0); PG8_MMA(1, 0, At, B0); PG8_BAR; PG8_SCHED;
            PG8_STAGE(PG8_SB(1, 1), b3 + hstep, voffB);
            PG8_WAIT_V(6); PG8_BAR; PG8_MMA(1, 1, At, B1); PG8_BAR;
            }
        }
        if constexpr (ALIGN_EPI) { if (wr == 0) PG8_BAR; }
        if constexpr (!Epi::AFTER_DRAIN) { E(acc, cur, wr, wc, fr, fq); S.done(cur); }
        if (!has_next) break;
#pragma unroll
        for (int a = 0; a < 2; ++a)
#pragma unroll
            for (int b = 0; b < 2; ++b)
#pragma unroll
                for (int m = 0; m < 4; ++m)
#pragma unroll
                    for (int n = 0; n < 2; ++n) acc[a][b][m][n] = (f32x4){0.f, 0.f, 0.f, 0.f};
        cur = nxt; cA = nA; cB = nB; ++ui;
        if constexpr (ALIGN_EPI) { if (wr == 1) PG8_BAR; }
    }
    PG8_WAIT_V(0);
    if constexpr (!ALIGN_EPI) { if (wr == 0) PG8_BAR; }
    PG8_BAR;
    if constexpr (Epi::AFTER_DRAIN) { E.fused(acc, cur, wr, wc, fr, fq, lds, wid, lane); S.done(cur); }
#undef PG8_SA
#undef PG8_SB
#undef PG8_STAGE
#undef PG8_LDA
#undef PG8_LDB
#undef PG8_MMA
#undef PG8_WAIT_V
#undef PG8_WAIT_L
#undef PG8_BAR
#undef PG8_SCHED
}
}
namespace pg8 {
__device__ __forceinline__ float gelu_tanh1(float x) {
    const float z = x * (0.7978845608028654f + 0.035677408136300125f * x * x);
    const float t = __builtin_amdgcn_exp2f(-2.8853900817779268f * z);
    return x * __builtin_amdgcn_rcpf(1.0f + t);
}
constexpr float RMS_EPS = 1e-6f;
struct EpiGateIn {
    static constexpr bool PERM = true, AFTER_DRAIN = false;
    bf16_t* gate; bf16_t* xin; const float* ss;
    __device__ __forceinline__ void operator()(const f32x4 (&acc)[2][2][4][2], const Unit& u, int wr, int wc, int fr, int fq) const {
        const int row0 = u.pm * BM + wr * 64 + fr;
#pragma unroll
        for (int ai = 0; ai < 2; ++ai)
#pragma unroll
            for (int m = 0; m < 4; ++m) {
                const int row = row0 + ai * HALF + m * 16;
                const float rs = __builtin_amdgcn_rsqf(ss[row] * (1.0f / 1024.0f) + RMS_EPS);
#pragma unroll
                for (int bj = 0; bj < 2; ++bj) {
                    const int h128 = u.pn * 2 + bj; const bool isg = h128 < 11;
                    bf16_t* rowp = (isg ? gate : xin) + (size_t)row * 1408 + (isg ? h128 : h128 - 11) * 128 + wc * 32 + 8 * fq;
                    f32x4 v0 = acc[ai][bj][m][0] * rs, v1 = acc[ai][bj][m][1] * rs;
                    if (isg) {
#pragma unroll
                        for (int e = 0; e < 4; ++e) { v0[e] = gelu_tanh1(v0[e]); v1[e] = gelu_tanh1(v1[e]); }
                    }
                    u32x4 w; w.x = cvt_pk_bf16(v0[0], v0[1]); w.y = cvt_pk_bf16(v0[2], v0[3]); w.z = cvt_pk_bf16(v1[0], v1[1]); w.w = cvt_pk_bf16(v1[2], v1[3]);
                    *(u32x4*)rowp = w;
                }
            }
    }
};
struct EpiScaleBf16 {
    static constexpr bool PERM = true, AFTER_DRAIN = false;
    bf16_t* O; int ldc; const float* ss;
    __device__ __forceinline__ void operator()(const f32x4 (&acc)[2][2][4][2], const Unit& u, int wr, int wc, int fr, int fq) const {
        const int row0 = u.pm * BM + wr * 64 + fr, col0 = u.pn * BM + wc * 32 + 8 * fq;
#pragma unroll
        for (int ai = 0; ai < 2; ++ai)
#pragma unroll
            for (int m = 0; m < 4; ++m) {
                const int row = row0 + ai * HALF + m * 16;
                const float rs = __builtin_amdgcn_rsqf(ss[row] * (1.0f / 1024.0f) + RMS_EPS);
                bf16_t* rowp = O + (size_t)row * ldc + col0;
#pragma unroll
                for (int bj = 0; bj < 2; ++bj) {
                    const f32x4 v0 = acc[ai][bj][m][0] * rs, v1 = acc[ai][bj][m][1] * rs;
                    u32x4 w; w.x = cvt_pk_bf16(v0[0], v0[1]); w.y = cvt_pk_bf16(v0[2], v0[3]); w.z = cvt_pk_bf16(v1[0], v1[1]); w.w = cvt_pk_bf16(v1[2], v1[3]);
                    *(u32x4*)(rowp + bj * HALF) = w;
                }
            }
    }
};
struct EpiQKV {
    static constexpr bool PERM = true, AFTER_DRAIN = false;
    bf16_t* q; float* k; float* v; const float* ss;
    __device__ __forceinline__ void operator()(const f32x4 (&acc)[2][2][4][2], const Unit& u, int wr, int wc, int fr, int fq) const {
        const int row0 = u.pm * BM + wr * 64 + fr, cw = wc * 32 + 8 * fq;
#pragma unroll
        for (int ai = 0; ai < 2; ++ai)
#pragma unroll
            for (int m = 0; m < 4; ++m) {
                const int row = row0 + ai * HALF + m * 16;
                const float rs = __builtin_amdgcn_rsqf(ss[row] * (1.0f / 1024.0f) + RMS_EPS);
#pragma unroll
                for (int bj = 0; bj < 2; ++bj) {
                    const f32x4 v0 = acc[ai][bj][m][0] * rs, v1 = acc[ai][bj][m][1] * rs;
                    if (u.pn < 4) {
                        u32x4 w; w.x = cvt_pk_bf16(v0[0], v0[1]); w.y = cvt_pk_bf16(v0[2], v0[3]); w.z = cvt_pk_bf16(v1[0], v1[1]); w.w = cvt_pk_bf16(v1[2], v1[3]);
                        *(u32x4*)(q + (size_t)row * 1024 + u.pn * BM + bj * HALF + cw) = w;
                    } else {
                        float* p = (bj == 0 ? k : v) + (size_t)row * 128 + cw;
                        *(f32x4*)p = v0; *(f32x4*)(p + 4) = v1;
                    }
                }
            }
    }
};
template <bool WITH_HB> struct EpiResid {
    static constexpr bool PERM = false, AFTER_DRAIN = false;
    const float* base; float* out; bf16_t* hb; float* ssq;
    __device__ __forceinline__ void operator()(const f32x4 (&acc)[2][2][4][2], const Unit& u, int wr, int wc, int fr, int fq) const {
        typedef unsigned u32x2v __attribute__((ext_vector_type(2)));
        const int row0 = u.pm * BM + wr * 64 + fr, col0 = u.pn * BM + wc * 32 + 4 * fq;
#pragma unroll
        for (int ai = 0; ai < 2; ++ai)
#pragma unroll
            for (int m = 0; m < 4; ++m) {
                const int row = row0 + ai * HALF + m * 16; const size_t off = (size_t)row * 1024 + col0; float s = 0.f;
#pragma unroll
                for (int bj = 0; bj < 2; ++bj)
#pragma unroll
                    for (int n = 0; n < 2; ++n) {
                        const f32x4 b = *(const f32x4*)(base + off + bj * HALF + n * 16);
                        const f32x4 o = b + acc[ai][bj][m][n];
                        *(f32x4*)(out + off + bj * HALF + n * 16) = o;
                        if (WITH_HB) {
                            s += (o[0] * o[0] + o[1] * o[1]) + (o[2] * o[2] + o[3] * o[3]);
                            u32x2v w; w.x = cvt_pk_bf16(o[0], o[1]); w.y = cvt_pk_bf16(o[2], o[3]);
                            *(u32x2v*)(hb + off + bj * HALF + n * 16) = w;
                        }
                    }
                if (WITH_HB) {
                    s += __shfl_xor(s, 16); s += __shfl_xor(s, 32);
                    if (fq == 0) atomicAdd(ssq + row, s);
                }
            }
    }
};
}
#define GAS __attribute__((address_space(1)))
#define LAS __attribute__((address_space(3)))
typedef unsigned short bf16;
typedef unsigned v4u __attribute__((ext_vector_type(4)));
typedef float f32x4 __attribute__((ext_vector_type(4)));
typedef short bf16x8 __attribute__((ext_vector_type(8)));
typedef GAS unsigned gu32;
typedef GAS unsigned long long gu64;
#define RLX_AGENT __ATOMIC_RELAXED, __HIP_MEMORY_SCOPE_AGENT
#define LDS_WAIT() asm volatile("s_waitcnt lgkmcnt(0)" ::: "memory")
#define VM_WAIT() asm volatile("s_waitcnt vmcnt(0)" ::: "memory")
__device__ __forceinline__ unsigned long long rt() { return __builtin_amdgcn_s_memrealtime(); }
__device__ __forceinline__ unsigned f2bf(float f) { unsigned u = __builtin_bit_cast(unsigned, f); return (u + 0x7fffu + ((u >> 16) & 1u)) >> 16; }
__device__ __forceinline__ unsigned pk2(float lo, float hi) { return f2bf(lo) | (f2bf(hi) << 16); }

#define XB_TMO      128
#define XB_XCNT(j)  (256  + 64 * (j))
#define XB_XSUB(j)  (1280 + 64 * (j))
#define XB_XGEN(j)  (2304 + 64 * (j))
#define XB_TOP      3328
#define XB_TOPGEN   3392
#define XCD_BAR_WORDS 3456
#define XB_SPIN_CAP (1u << 18)

__device__ __forceinline__ unsigned xb_ld(unsigned* p)              { return __hip_atomic_load(p, __ATOMIC_RELAXED, __HIP_MEMORY_SCOPE_AGENT); }
__device__ __forceinline__ unsigned xb_add(unsigned* p, unsigned v) { return __hip_atomic_fetch_add(p, v, __ATOMIC_RELAXED, __HIP_MEMORY_SCOPE_AGENT); }
__device__ __forceinline__ unsigned xb_xcc_id() { return (unsigned)__builtin_amdgcn_s_getreg((3 << 11) | 20) & 0xFu; }
#define XB_SPIN(cond, bar) do { unsigned _sp = 0; while (cond) { __builtin_amdgcn_s_sleep(1); \
    if ((++_sp & 255u) == 0u) { if (xb_ld(&(bar)[XB_TMO])) break; if (_sp > XB_SPIN_CAP) { atomicAdd(&(bar)[XB_TMO], 1u); break; } } } } while (0)

struct XcdBarrier {
    unsigned* bar; unsigned x;
    volatile LAS unsigned* st;
};

__device__ __forceinline__ XcdBarrier xcd_barrier_post(unsigned* bar, volatile LAS unsigned* st) {
    XcdBarrier b; b.bar = bar; b.x = xb_xcc_id(); b.st = st;
    if (threadIdx.x == 0) (void)xb_add(&bar[XB_XCNT(b.x)], 1u);
    return b;
}
__device__ __forceinline__ void xcd_barrier_complete(unsigned* bar, unsigned x, unsigned& nloc, unsigned& nx) {
    const unsigned G = gridDim.x * gridDim.y * gridDim.z;
    unsigned sum, cnt, mine, sp = 0u;
    for (;;) {
        sum = 0u; cnt = 0u; mine = 0u;
#pragma unroll
        for (unsigned j = 0; j < 16; ++j) { const unsigned c = xb_ld(&bar[XB_XCNT(j)]); sum += c; cnt += (c > 0u) ? 1u : 0u; mine = (j == x) ? c : mine; }
        if (sum == G) break;
        __builtin_amdgcn_s_sleep(1);
        if ((++sp & 255u) == 0u) { if (xb_ld(&bar[XB_TMO])) break; if (sp > XB_SPIN_CAP) { atomicAdd(&bar[XB_TMO], 1u); break; } }
    }
    nloc = mine > 0u ? mine : 1u; nx = cnt > 0u ? cnt : 1u;
}

__device__ __forceinline__ void xcd_barrier(const XcdBarrier& b) {
    asm volatile("s_waitcnt vmcnt(0)" ::: "memory");
    __syncthreads();
    if (threadIdx.x == 0) {
        unsigned* bar = b.bar;
        __builtin_amdgcn_s_waitcnt(0);
        unsigned nloc = b.st[0], nx = b.st[1];
        if (nloc == 0u) { xcd_barrier_complete(bar, b.x, nloc, nx); b.st[0] = nloc; b.st[1] = nx; }
        const unsigned old = xb_add(&bar[XB_XSUB(b.x)], 1u);
        const unsigned gen = old / nloc;
        if (old + 1u == (gen + 1u) * nloc) {
            __builtin_amdgcn_fence(__ATOMIC_RELEASE, "agent");
            asm volatile("s_waitcnt vmcnt(0)" ::: "memory");
            const unsigned og = xb_add(&bar[XB_TOP], 1u);
            const unsigned tg = og / nx;
            if (og + 1u == (tg + 1u) * nx) xb_add(&bar[XB_TOPGEN], 1u);
            else XB_SPIN(xb_ld(&bar[XB_TOPGEN]) == tg, bar);
            __builtin_amdgcn_fence(__ATOMIC_ACQUIRE, "agent");
            xb_add(&bar[XB_XGEN(b.x)], 1u);
            asm volatile("s_waitcnt vmcnt(0)" ::: "memory");
        } else {
            XB_SPIN(xb_ld(&bar[XB_XGEN(b.x)]) == gen, bar);
            __builtin_amdgcn_fence(__ATOMIC_ACQUIRE, "agent");
            asm volatile("s_waitcnt vmcnt(0)" ::: "memory");
        }
    }
    __syncthreads();
}
constexpr int BATCH = 16, SEQ = 2048, D = 1024, M = BATCH * SEQ;
constexpr int LW = 1344, LWP = 1408, NBLK = 8, BDIM = 168;
constexpr int FF = 3072, FF2 = 6144, NH = 16, NKV = 2, HD = 64;
constexpr int N1 = 2 * LWP;
constexpr int NQKV = 1280;
enum { I_X = 0, I_POS, I_ANORM, I_WGATE, I_WIN, I_ACONVW, I_ACONVB, I_WRG, I_BRG, I_WIG, I_BIG, I_LAM, I_WOUT, I_KVNORM, I_WK, I_WV, I_KNORM, I_BNORM, I_WQ, I_QNORM, I_SINKS, I_WO, I_FNORM, I_WUP, I_FCONVW, I_FCONVB, I_WDOWN, N_IN };
constexpr size_t MiB = 1u << 20;
constexpr size_t WS_CTL = 0, CTL_ZERO_BYTES = 1 * MiB;
constexpr size_t WS_SSQ = 256 * 1024;
constexpr size_t WS_SS0 = 640 * 1024;
constexpr size_t WS_ROPE = 1 * MiB;
constexpr size_t WS_W1T = 4 * MiB, WS_WOUTT = 10 * MiB, WS_WUPT = 13 * MiB  , WS_WDOWNT = 37 * MiB  , WS_WQKVT = 49 * MiB, WS_WOT = 52 * MiB;
constexpr size_t WS_HB = 64 * MiB;
constexpr size_t WS_GATE = 128 * MiB, WS_XIN = 216 * MiB;
constexpr size_t WS_XR = 304 * MiB;
constexpr size_t WS_ACT = 128 * MiB;
constexpr size_t WS_UPH = 320 * MiB;
constexpr size_t WS_Q = 128 * MiB, WS_AO = 192 * MiB;
constexpr size_t WS_KRAW = 256 * MiB, WS_VRAW = 272 * MiB, WS_KN = 288 * MiB;
constexpr size_t WS_END = 512 * MiB;

__device__ __forceinline__ float bf2f(unsigned short h) { return __builtin_bit_cast(float, (unsigned)h << 16); }
__device__ __forceinline__ float gelu_tanh(float x) { const float z = x * (0.7978845608028654f + 0.035677408136300125f * x * x); return x / (1.0f + __expf(-2.0f * z)); }

__global__ void __launch_bounds__(256) k_wt(const float* __restrict__ W, int Ksrc, int Nsrc, int ld, const float* __restrict__ g, bf16* __restrict__ Wt, int Kout, int mode) {
    __shared__ float tile[32][33];
    const int k0 = blockIdx.x * 32, n0 = blockIdx.y * 32, tx = threadIdx.x & 31, ty = threadIdx.x >> 5;
#pragma unroll
    for (int j = 0; j < 4; ++j) {
        const int k = k0 + ty + 8 * j, n = n0 + tx;
        const int ns = mode == 2 ? (((n & 255) >> 7) ? 3072 : 0) + 128 * (n >> 8) + (n & 127) : n;
        float v = 0.f;
        if (k < Ksrc && ns < Nsrc) v = W[(size_t)k * ld + ns] * (g ? g[k] : 1.0f);
        tile[ty + 8 * j][tx] = v;
    }
    __syncthreads();
#pragma unroll
    for (int j = 0; j < 4; ++j) {
        const int n = n0 + ty + 8 * j, k = k0 + tx;
        Wt[(size_t)n * Kout + k] = (bf16)f2bf(tile[tx][ty + 8 * j]);
    }
}
__global__ void __launch_bounds__(256) k_xprep(const float* __restrict__ x, bf16* __restrict__ xb, float* __restrict__ ss0) {
    typedef float f32x4 __attribute__((ext_vector_type(4)));
    const int lane = threadIdx.x & 63, row = blockIdx.x * 4 + (threadIdx.x >> 6);
    const f32x4* xr = (const f32x4*)(x + (size_t)row * D) + lane;
    unsigned long long* o8 = (unsigned long long*)(xb + (size_t)row * D) + lane;
    float s = 0.f;
#pragma unroll
    for (int j = 0; j < 4; ++j) {
        const f32x4 v = xr[64 * j]; s += (v.x * v.x + v.y * v.y) + (v.z * v.z + v.w * v.w);
        o8[64 * j] = (unsigned long long)(f2bf(v.x) | (f2bf(v.y) << 16)) | ((unsigned long long)(f2bf(v.z) | (f2bf(v.w) << 16)) << 32);
    }
#pragma unroll
    for (int o = 1; o < 64; o <<= 1) s += __shfl_xor(s, o);
    if (lane == 0) ss0[row] = s;
}
struct RopeFreq { float f[8]; };
__global__ void __launch_bounds__(256) k_rope(const int* __restrict__ pos, float* __restrict__ cs, RopeFreq rf) {
    const int idx = blockIdx.x * 256 + threadIdx.x, m = idx >> 3, i = idx & 7;
    const float ang = (float)pos[m] * rf.f[i];
    cs[(size_t)idx * 2] = cosf(ang); cs[(size_t)idx * 2 + 1] = sinf(ang);
}
__global__ void __launch_bounds__(256) k_conv4(const bf16* __restrict__ xin, const float* __restrict__ cw, const float* __restrict__ cb, float* __restrict__ xr) {
    const size_t idx = (size_t)blockIdx.x * 256 + threadIdx.x; if (idx >= (size_t)M * LW) return;
    const int m = (int)(idx / LW), c = (int)(idx % LW), t = m % SEQ;
    float v = cb[c];
#pragma unroll
    for (int k = 0; k < 4; ++k) if (t - 3 + k >= 0) v += bf2f(xin[(size_t)(m - 3 + k) * LWP + c]) * cw[k * LW + c];
    xr[idx] = v;
}
__global__ void __launch_bounds__(192) k_scan(const float* __restrict__ xr, const float* __restrict__ wrg, const float* __restrict__ brg, const float* __restrict__ wig, const float* __restrict__ big,
                                              const float* __restrict__ lam, bf16* gate) {
    const int b = blockIdx.x >> 3, hb = blockIdx.x & 7, j = threadIdx.x; if (j >= BDIM) return;
    const int c = hb * BDIM + j;
    const float* wr = wrg + (size_t)hb * BDIM * BDIM + j; const float* wi = wig + (size_t)hb * BDIM * BDIM + j;
    const float br = brg[c], bi = big[c];
    const float lm = lam[c]; const float sp = (lm < 0.f ? -lm : 0.f) + log1pf(expf(-fabsf(lm)));
    float h = 0.f;
    for (int t = 0; t < SEQ; ++t) {
        const size_t m = (size_t)b * SEQ + t; const float* xrow = xr + m * LW + hb * BDIM;
        float zr = br, zi = bi;
        for (int i = 0; i < BDIM; ++i) { const float xv = xrow[i]; zr += xv * wr[(size_t)i * BDIM]; zi += xv * wi[(size_t)i * BDIM]; }
        const float r = 1.0f / (1.0f + expf(-zr)), ig = 1.0f / (1.0f + expf(-zi));
        const float log_a = -8.0f * r * sp, a = expf(log_a), mult = sqrtf(-expm1f(2.0f * log_a));
        h = a * h + mult * ig * xrow[j];
        const size_t go = m * LWP + c;
        gate[go] = (bf16)f2bf(bf2f(gate[go]) * h);
    }
}
__global__ void __launch_bounds__(256) k_convffn(const bf16* __restrict__ uph, const float* __restrict__ cw, const float* __restrict__ cb, bf16* __restrict__ act, int mbase) {
    const size_t idx = (size_t)blockIdx.x * 256 + threadIdx.x;
    const int mh = (int)(idx / FF), c = (int)(idx % FF), m = mbase + mh, t = m % SEQ;
    const int ng = (c >> 7) * 256 + (c & 127), nv = ng + 128;
    float g = cb[c], v = cb[FF + c];
#pragma unroll
    for (int k = 0; k < 3; ++k) if (t - 2 + k >= 0) { const size_t r = (size_t)(mh - 2 + k) * FF2; g += bf2f(uph[r + ng]) * cw[k * FF2 + c]; v += bf2f(uph[r + nv]) * cw[k * FF2 + FF + c]; }
    act[(size_t)m * FF + c] = (bf16)f2bf(gelu_tanh(g) * v);
}
__global__ void __launch_bounds__(256) k_knorm(const float* __restrict__ kraw, const float* __restrict__ knorm, const float* __restrict__ cs, float* __restrict__ kn) {
    const int idx = blockIdx.x * 256 + threadIdx.x, m = idx >> 1, kvh = idx & 1;
    const float* kr = kraw + (size_t)m * 128 + kvh * 64; float kv[64]; float s = 0.f;
#pragma unroll
    for (int d = 0; d < 64; ++d) { kv[d] = kr[d]; s += kv[d] * kv[d]; }
    const float rs = rsqrtf(s * (1.0f / 64.0f) + 1e-6f);
#pragma unroll
    for (int d = 0; d < 64; ++d) kv[d] = kv[d] * rs * knorm[d];
    float* o = kn + (size_t)m * 128 + kvh * 64;
#pragma unroll
    for (int i = 0; i < 8; ++i) { const float c = cs[((size_t)m * 8 + i) * 2], sn = cs[((size_t)m * 8 + i) * 2 + 1]; const float x1 = kv[i], x2 = kv[8 + i]; o[i] = x1 * c - x2 * sn; o[8 + i] = x2 * c + x1 * sn; }
#pragma unroll
    for (int d = 16; d < 64; ++d) o[d] = kv[d];
}
__global__ void __launch_bounds__(256) k_attn(const bf16* __restrict__ q, const float* __restrict__ kn, const float* __restrict__ vraw, const float* __restrict__ qnorm, const float* __restrict__ sinks,
                                              const float* __restrict__ cs, bf16* __restrict__ ao) {
    const int idx = blockIdx.x * 256 + threadIdx.x, m = idx >> 4, h = idx & 15, kvh = h >> 3, t = m % SEQ;
    float qv[64]; float s = 0.f;
#pragma unroll
    for (int d = 0; d < 64; ++d) { qv[d] = bf2f(q[(size_t)m * 1024 + h * 64 + d]); s += qv[d] * qv[d]; }
    const float rs = rsqrtf(s * (1.0f / 64.0f) + 1e-6f) * 0.125f;
#pragma unroll
    for (int d = 0; d < 64; ++d) qv[d] = qv[d] * rs * qnorm[d];
#pragma unroll
    for (int i = 0; i < 8; ++i) { const float c = cs[((size_t)m * 8 + i) * 2], sn = cs[((size_t)m * 8 + i) * 2 + 1]; const float x1 = qv[i], x2 = qv[8 + i]; qv[i] = x1 * c - x2 * sn; qv[8 + i] = x2 * c + x1 * sn; }
    float mx = sinks[h], l = 1.0f; float acc[64];
#pragma unroll
    for (int d = 0; d < 64; ++d) acc[d] = 0.f;
    const int klo = t - 127 < 0 ? 0 : t - 127;
    for (int kk = klo; kk <= t; ++kk) {
        const size_t mk = (size_t)(m - t + kk) * 128 + kvh * 64; float sc = 0.f;
#pragma unroll
        for (int d = 0; d < 64; ++d) sc += qv[d] * kn[mk + d];
        const float mn = fmaxf(mx, sc), f = __expf(mx - mn), p = __expf(sc - mn);
        l = l * f + p; mx = mn;
#pragma unroll
        for (int d = 0; d < 64; ++d) acc[d] = acc[d] * f + p * vraw[mk + d];
    }
    const float il = 1.0f / l;
#pragma unroll
    for (int d = 0; d < 64; ++d) ao[(size_t)m * 1024 + h * 64 + d] = (bf16)f2bf(acc[d] * il);
}
constexpr int NWAVES = 8;
constexpr int RING_OFF = 0, RING_BYTES = 131072;
constexpr int LDSCTL_OFF = RING_BYTES, MISC_OFF = LDSCTL_OFF + 320;
constexpr int LDS_BYTES = 147456;

struct Args { const void* in[N_IN]; float* out; unsigned char* ws; int ph; int pad; };

enum { PH_G1 = 1, PH_G2, PH_UP0A, PH_UP0B, PH_DOWN0, PH_QKV, PH_WO, PH_UP1A, PH_UP1B, PH_DOWN1 };

__global__ void __launch_bounds__(NWAVES * 64, 2) skel_fwd(Args args) {
    extern __shared__ __attribute__((aligned(16))) unsigned char lds[];
    LAS unsigned char* L = (LAS unsigned char*)lds;
    unsigned char* ws = args.ws;
    const int G = gridDim.x, ph = args.ph;
    const float* x = (const float*)args.in[I_X];
    float* ssq = (float*)(ws + WS_SSQ);
    const float* ss0 = (const float*)(ws + WS_SS0);
    bf16* HB = (bf16*)(ws + WS_HB);
    if (ph == PH_G1) {
        pg8::Gemm g{HB, (const bf16*)(ws + WS_W1T), M, N1, D}; pg8::StaticOrder S; S.init(M, N1, G, (int)blockIdx.x);
        pg8::EpiGateIn E{(bf16*)(ws + WS_GATE), (bf16*)(ws + WS_XIN), ss0};
        pg8::gemm_phase<pg8::EpiGateIn, pg8::StaticOrder, true, true>(L + RING_OFF, g, S, E);
    } else if (ph == PH_G2) {
        pg8::Gemm g{(const bf16*)(ws + WS_GATE), (const bf16*)(ws + WS_WOUTT), M, D, LWP}; pg8::StaticOrder S; S.init(M, D, G, (int)blockIdx.x);
        pg8::EpiResid<true> E{x, args.out, HB, ssq};
        pg8::gemm_phase<pg8::EpiResid<true>, pg8::StaticOrder, true, true>(L + RING_OFF, g, S, E);
    } else if (ph == PH_UP0A || ph == PH_UP0B || ph == PH_UP1A || ph == PH_UP1B) {
        const int layer = (ph == PH_UP1A || ph == PH_UP1B) ? 1 : 0, half = (ph == PH_UP0B || ph == PH_UP1B) ? 1 : 0;
        pg8::Gemm g{HB + (size_t)half * (M / 2) * D, (const bf16*)(ws + WS_WUPT) + (size_t)layer * FF2 * D, M / 2, FF2, D}; pg8::StaticOrder S; S.init(M / 2, FF2, G, (int)blockIdx.x);
        pg8::EpiScaleBf16 E{(bf16*)(ws + WS_UPH), FF2, ssq + (size_t)(layer == 0 ? 0 : 2) * M + (size_t)half * (M / 2)};
        pg8::gemm_phase<pg8::EpiScaleBf16, pg8::StaticOrder, true, true>(L + RING_OFF, g, S, E);
    } else if (ph == PH_DOWN0) {
        pg8::Gemm g{(const bf16*)(ws + WS_ACT), (const bf16*)(ws + WS_WDOWNT), M, D, FF}; pg8::StaticOrder S; S.init(M, D, G, (int)blockIdx.x);
        pg8::EpiResid<true> E{args.out, args.out, HB, ssq + M};
        pg8::gemm_phase<pg8::EpiResid<true>, pg8::StaticOrder, true, true>(L + RING_OFF, g, S, E);
    } else if (ph == PH_QKV) {
        pg8::Gemm g{HB, (const bf16*)(ws + WS_WQKVT), M, NQKV, D}; pg8::StaticOrder S; S.init(M, NQKV, G, (int)blockIdx.x);
        pg8::EpiQKV E{(bf16*)(ws + WS_Q), (float*)(ws + WS_KRAW), (float*)(ws + WS_VRAW), ssq + M};
        pg8::gemm_phase<pg8::EpiQKV, pg8::StaticOrder, true, true>(L + RING_OFF, g, S, E);
    } else if (ph == PH_WO) {
        pg8::Gemm g{(const bf16*)(ws + WS_AO), (const bf16*)(ws + WS_WOT), M, D, D}; pg8::StaticOrder S; S.init(M, D, G, (int)blockIdx.x);
        pg8::EpiResid<true> E{args.out, args.out, HB, ssq + 2 * (size_t)M};
        pg8::gemm_phase<pg8::EpiResid<true>, pg8::StaticOrder, true, true>(L + RING_OFF, g, S, E);
    } else if (ph == PH_DOWN1) {
        pg8::Gemm g{(const bf16*)(ws + WS_ACT), (const bf16*)(ws + WS_WDOWNT) + (size_t)D * FF, M, D, FF}; pg8::StaticOrder S; S.init(M, D, G, (int)blockIdx.x);
        pg8::EpiResid<false> E{args.out, args.out, nullptr, nullptr};
        pg8::gemm_phase<pg8::EpiResid<false>, pg8::StaticOrder, true, true>(L + RING_OFF, g, S, E);
    }
}

extern "C" void kernel_launch(void* const* d_in, const int* in_sizes, int n_in, void* d_out, int out_size, void* d_ws, size_t ws_size, hipStream_t stream) {
    static int grid = 0;
    if (grid == 0) {
        if (n_in != N_IN || in_sizes[0] != M * D || out_size != M * D || ws_size < WS_END) { fprintf(stderr, "kernel_launch: shape/workspace mismatch (n_in %d, in0 %d, out %d, ws %zu)\n", n_in, n_in > 0 ? in_sizes[0] : -1, out_size, ws_size); grid = -1; return; }
        int dev = 0, cus = 0;
        if (hipGetDevice(&dev) != hipSuccess || hipDeviceGetAttribute(&cus, hipDeviceAttributeMultiprocessorCount, dev) != hipSuccess) { grid = -1; return; }
        if (hipFuncSetAttribute((const void*)skel_fwd, hipFuncAttributeMaxDynamicSharedMemorySize, LDS_BYTES) != hipSuccess) { fprintf(stderr, "kernel_launch: hipFuncSetAttribute failed\n"); grid = -1; return; }
        (void)hipGetLastError();
        grid = cus;
    }
    if (grid < 0) return;
    unsigned char* ws = (unsigned char*)d_ws;
    auto F = [&](int i) { return (const float*)d_in[i]; };
    (void)hipMemsetAsync(ws + WS_CTL, 0, CTL_ZERO_BYTES, stream);
    auto wt = [&](const float* W, int Ksrc, int Nsrc, int ld, const float* g, bf16* Wt, int Nout, int Kout, int mode) {
        hipLaunchKernelGGL(k_wt, dim3(Kout / 32, Nout / 32), dim3(256), 0, stream, W, Ksrc, Nsrc, ld, g, Wt, Kout, mode); };
    wt(F(I_WGATE), D, LW, LW, F(I_ANORM), (bf16*)(ws + WS_W1T), LWP, D, 0);
    wt(F(I_WIN), D, LW, LW, F(I_ANORM), (bf16*)(ws + WS_W1T) + (size_t)LWP * D, LWP, D, 0);
    wt(F(I_WOUT), LW, D, D, nullptr, (bf16*)(ws + WS_WOUTT), D, LWP, 0);
    for (int l = 0; l < 2; ++l) {
        wt(F(I_WUP) + (size_t)l * D * FF2, D, FF2, FF2, F(I_FNORM) + l * D, (bf16*)(ws + WS_WUPT) + (size_t)l * FF2 * D, FF2, D, 2);
        wt(F(I_WDOWN) + (size_t)l * FF * D, FF, D, D, nullptr, (bf16*)(ws + WS_WDOWNT) + (size_t)l * D * FF, D, FF, 0);
    }
    wt(F(I_WQ), D, 1024, 1024, F(I_BNORM), (bf16*)(ws + WS_WQKVT), 1024, D, 0);
    wt(F(I_WK), D, 128, 128, F(I_KVNORM), (bf16*)(ws + WS_WQKVT) + (size_t)1024 * D, 128, D, 0);
    wt(F(I_WV), D, 128, 128, F(I_KVNORM), (bf16*)(ws + WS_WQKVT) + (size_t)1152 * D, 128, D, 0);
    wt(F(I_WO), D, D, D, nullptr, (bf16*)(ws + WS_WOT), D, D, 0);
    hipLaunchKernelGGL(k_xprep, dim3(M / 4), dim3(256), 0, stream, F(I_X), (bf16*)(ws + WS_HB), (float*)(ws + WS_SS0));
    RopeFreq rf; for (int i = 0; i < 8; ++i) rf.f[i] = (float)pow(500000.0, -(double)i / 8.0);
    hipLaunchKernelGGL(k_rope, dim3(M * 8 / 256), dim3(256), 0, stream, (const int*)d_in[I_POS], (float*)(ws + WS_ROPE), rf);

    Args a{};
    for (int i = 0; i < N_IN; ++i) a.in[i] = d_in[i];
    a.out = (float*)d_out; a.ws = ws;
    auto gemm = [&](int ph) { a.ph = ph; hipLaunchKernelGGL(skel_fwd, dim3(grid), dim3(NWAVES * 64), LDS_BYTES, stream, a); };
    gemm(PH_G1);
    hipLaunchKernelGGL(k_conv4, dim3((unsigned)((size_t)M * LW / 256)), dim3(256), 0, stream, (const bf16*)(ws + WS_XIN), F(I_ACONVW), F(I_ACONVB), (float*)(ws + WS_XR));
    hipLaunchKernelGGL(k_scan, dim3(BATCH * NBLK), dim3(192), 0, stream, (const float*)(ws + WS_XR), F(I_WRG), F(I_BRG), F(I_WIG), F(I_BIG), F(I_LAM), (bf16*)(ws + WS_GATE));
    gemm(PH_G2);
    for (int l = 0; l < 2; ++l) {
        for (int half = 0; half < 2; ++half) {
            gemm(l == 0 ? (half ? PH_UP0B : PH_UP0A) : (half ? PH_UP1B : PH_UP1A));
            hipLaunchKernelGGL(k_convffn, dim3((unsigned)((size_t)(M / 2) * FF / 256)), dim3(256), 0, stream, (const bf16*)(ws + WS_UPH), F(I_FCONVW) + (size_t)l * 3 * FF2, F(I_FCONVB) + (size_t)l * FF2,
                               (bf16*)(ws + WS_ACT), half * (M / 2));
        }
        gemm(l == 0 ? PH_DOWN0 : PH_DOWN1);
        if (l == 0) {
            gemm(PH_QKV);
            hipLaunchKernelGGL(k_knorm, dim3(M * 2 / 256), dim3(256), 0, stream, (const float*)(ws + WS_KRAW), F(I_KNORM), (const float*)(ws + WS_ROPE), (float*)(ws + WS_KN));
            hipLaunchKernelGGL(k_attn, dim3(M * 16 / 256), dim3(256), 0, stream, (const bf16*)(ws + WS_Q), (const float*)(ws + WS_KN), (const float*)(ws + WS_VRAW), F(I_QNORM), F(I_SINKS),
                               (const float*)(ws + WS_ROPE), (bf16*)(ws + WS_AO));
            gemm(PH_WO);
        }
    }
}
```

```cpp
#include <hip/hip_runtime.h>
#include <cstdio>
#include <cstdint>
__device__ __forceinline__ int pg8_fresh_tid(int wid_s) {
    int l; asm volatile("v_mbcnt_lo_u32_b32 %0, -1, 0\n\tv_mbcnt_hi_u32_b32 %0, -1, %0" : "=v"(l));
    return wid_s * 64 + l;
}
namespace pg8 {
#define PG8_LAS __attribute__((address_space(3)))
typedef unsigned short bf16_t;
typedef short bf16x8 __attribute__((ext_vector_type(8)));
typedef float f32x4 __attribute__((ext_vector_type(4)));
typedef unsigned u32x4 __attribute__((ext_vector_type(4)));
constexpr int BM = 256, BK = 64, HALF = 128, HTB = HALF * BK * 2  , STAGE_BYTES = 8 * HTB, NXCD = 8, WGM = 8;

__host__ __device__ __forceinline__ int lds_byte(int r, int c) { const int st = (r >> 4) * 2 + (c >> 5), rr = r & 15, cc = c & 31, ob = rr * 64 + cc * 2; return st * 1024 + (ob ^ (((ob >> 9) & 1) << 5)); }
__host__ __device__ __forceinline__ void stage_rc(int b, int& R, int& C) { const int st = b / 1024, sb = b % 1024, swz = sb ^ (((sb >> 9) & 1) << 5); R = (st >> 1) * 16 + swz / 64; C = (st & 1) * 32 + (swz % 64) / 2; }
__host__ __device__ __forceinline__ int perm32(int rho) { const int n = rho >> 4, i = rho & 15; return 8 * (i >> 2) + 4 * n + (i & 3); }

struct Unit { int pm, pn; };
struct Gemm { const bf16_t* A; const bf16_t* Bt; int M, N, K; };

struct StaticOrder {
    int nM, nN, nwg, G, c;
    __host__ __device__ void init(int M, int N, int G_, int c_) { nM = M / BM; nN = N / BM; nwg = nM * nN; G = G_; c = c_; }
    __host__ __device__ bool next(int i, Unit& u) const {
        const long L = (long)i * G + c; if (L >= nwg) return false;
        int wgid = (int)L; { const int q = nwg / NXCD, r = nwg % NXCD, xcd = wgid % NXCD, off = wgid / NXCD; wgid = (xcd < r ? xcd * (q + 1) : r * (q + 1) + (xcd - r) * q) + off; }
        const int nig = WGM * nN, gid = wgid / nig, fm = gid * WGM, gsz = (nM - fm) < WGM ? (nM - fm) : WGM;
        u.pm = fm + ((wgid % nig) % gsz); u.pn = (wgid % nig) / gsz; return true;
    }
    __device__ __forceinline__ void a_ready(const Unit&) const {}
    __device__ __forceinline__ void done(const Unit&) const {}
};

__device__ __forceinline__ unsigned cvt_pk_bf16(float lo, float hi) { unsigned r; asm volatile("v_cvt_pk_bf16_f32 %0, %1, %2" : "=v"(r) : "v"(lo), "v"(hi)); return r; }
typedef float f32x2 __attribute__((ext_vector_type(2)));
__device__ __forceinline__ f32x2 gelu_pk(f32x2 v) {
    const f32x2 av = __builtin_elementwise_abs(v), d = av * 0.2316418882f + 1.0f;
    f32x2 t; t.x = __builtin_amdgcn_rcpf(d.x); t.y = __builtin_amdgcn_rcpf(d.y);
    f32x2 q = t * 0.5307027145f + (-0.7265760135f); q = q * t + 0.7107068705f; q = q * t + (-0.142248368f); q = q * t + 0.127414796f; q = q * t;
    const f32x2 s = (v * v) * (-0.72134752044f);
    f32x2 e; e.x = __builtin_amdgcn_exp2f(s.x); e.y = __builtin_amdgcn_exp2f(s.y);
    const f32x2 m = v * (q * e), r = v - m;
    f32x2 o; o.x = v.x < 0.f ? m.x : r.x; o.y = v.y < 0.f ? m.y : r.y; return o;
}

template <int ACT  > struct EpiBf16 {
    static constexpr bool PERM = true, AFTER_DRAIN = false; static_assert(ACT == 0 || ACT == 1, "EpiBf16: ACT is 0 (none) or 1 (gelu_pk)");
    bf16_t* O; int ldc; const float* bias; int split_cols; size_t split_stride; float scale0;
    __device__ __forceinline__ void operator()(const f32x4 (&acc)[2][2][4][2], const Unit& u, int wr, int wc, int fr, int fq) const {
        const int row0 = u.pm * BM + wr * 64 + fr; int colt = u.pn * BM; bf16_t* base = O;
        float sc = 1.f; if (split_cols) { const int t = colt / split_cols; base += (size_t)t * split_stride; colt -= t * split_cols; if (t == 0) sc = scale0; }
        const int col0 = colt + wc * 32 + 8 * fq, bcol0 = u.pn * BM + wc * 32 + 8 * fq;
        f32x4 bv[2][2];
#pragma unroll
        for (int bj = 0; bj < 2; ++bj)
#pragma unroll
            for (int n = 0; n < 2; ++n) bv[bj][n] = bias ? *(const f32x4*)(bias + bcol0 + bj * HALF + 4 * n) : (f32x4){0.f, 0.f, 0.f, 0.f};
#pragma unroll
        for (int ai = 0; ai < 2; ++ai)
#pragma unroll
            for (int m = 0; m < 4; ++m) { bf16_t* rowp = base + (size_t)(row0 + ai * HALF + m * 16) * ldc + col0;
#pragma unroll
                for (int bj = 0; bj < 2; ++bj) { f32x4 v0 = acc[ai][bj][m][0] + bv[bj][0], v1 = acc[ai][bj][m][1] + bv[bj][1];
                    if (ACT == 1) { f32x2 a = gelu_pk((f32x2){v0[0], v0[1]}), b = gelu_pk((f32x2){v0[2], v0[3]}), c = gelu_pk((f32x2){v1[0], v1[1]}), d = gelu_pk((f32x2){v1[2], v1[3]});
                        v0 = (f32x4){a.x, a.y, b.x, b.y}; v1 = (f32x4){c.x, c.y, d.x, d.y}; }
                    v0 = v0 * sc; v1 = v1 * sc; u32x4 w; w.x = cvt_pk_bf16(v0[0], v0[1]); w.y = cvt_pk_bf16(v0[2], v0[3]); w.z = cvt_pk_bf16(v1[0], v1[1]); w.w = cvt_pk_bf16(v1[2], v1[3]);
                    *(u32x4*)(rowp + bj * HALF) = w; } }
    }
};
template <class Epi, class Sched, bool ALIGN_EPI = false, bool SP2 = false>
__device__ __forceinline__ void gemm_phase(PG8_LAS unsigned char* lds, const Gemm g, const Sched& S, const Epi& E, const int wid_s) {
    const int tid = pg8_fresh_tid(wid_s),
        wid = __builtin_amdgcn_readfirstlane(tid >> 6), lane = tid & 63, wr = wid >> 2, wc = wid & 3, fr = lane & 15, fq = lane >> 4;
    const int K = g.K, nt = K / BK;
    unsigned voffA[2], voffB[2];
#pragma unroll
    for (int i = 0; i < 2; ++i) { int R, C; stage_rc(tid * 16 + i * 8192, R, C); const int Rb = Epi::PERM ? ((R & ~31) + perm32(R & 31)) : R;
        voffA[i] = (unsigned)(R * K + C) * 2u; voffB[i] = (unsigned)(Rb * K + C) * 2u; }
    const size_t kstep = (size_t)(BK * 2);
    const size_t hstep = (size_t)HALF * K * 2;
    const size_t tstep = 2 * hstep;
    const unsigned ldsw = (unsigned)wid * 1024u;
    const int aoff = lds_byte(wr * 64 + fr, fq * 8), boff = lds_byte(wc * 32 + fr, fq * 8);
#define PG8_SA(b, h) (((b) * 2 + (h)) * HTB)
#define PG8_SB(b, h) ((4 + (b) * 2 + (h)) * HTB)
#define PG8_STAGE(bufoff, gbase, voff) do { _Pragma("unroll") for (int _i = 0; _i < 2; ++_i) \
        __builtin_amdgcn_global_load_lds((const unsigned*)((const char*)(gbase) + (voff)[_i]), (PG8_LAS unsigned*)(lds + (bufoff) + ldsw + _i * 8192), 16, 0, 0); } while (0)
#define PG8_LDA(dst, b, h) do { _Pragma("unroll") for (int m = 0; m < 4; ++m) _Pragma("unroll") for (int k = 0; k < 2; ++k) dst[m][k] = *(const PG8_LAS bf16x8*)(lds + PG8_SA(b, h) + aoff + m * 2048 + k * 1024); } while (0)
#define PG8_LDB(dst, b, h) do { _Pragma("unroll") for (int n = 0; n < 2; ++n) _Pragma("unroll") for (int k = 0; k < 2; ++k) dst[n][k] = *(const PG8_LAS bf16x8*)(lds + PG8_SB(b, h) + boff + n * 2048 + k * 1024); } while (0)
#define PG8_MMA(ai, bj, At, Bt) do { __builtin_amdgcn_s_setprio(1); _Pragma("unroll") for (int m = 0; m < 4; ++m) _Pragma("unroll") for (int n = 0; n < 2; ++n) _Pragma("unroll") for (int k = 0; k < 2; ++k) \
        acc[ai][bj][m][n] = __builtin_amdgcn_mfma_f32_16x16x32_bf16(Bt[n][k], At[m][k], acc[ai][bj][m][n], 0, 0, 0); __builtin_amdgcn_s_setprio(0); } while (0)
#define PG8_WAIT_V(n) asm volatile("s_waitcnt vmcnt(" #n ")" ::: "memory")
#define PG8_WAIT_L(n) asm volatile("s_waitcnt lgkmcnt(" #n ")" ::: "memory")
#define PG8_BAR __builtin_amdgcn_s_barrier()
#define PG8_SCHED __builtin_amdgcn_sched_barrier(0)
    Unit cur, nxt; int ui = 0;
    if (!S.next(0, cur)) return;
    f32x4 acc[2][2][4][2];
#pragma unroll
    for (int a = 0; a < 2; ++a)
#pragma unroll
        for (int b = 0; b < 2; ++b)
#pragma unroll
            for (int m = 0; m < 4; ++m)
#pragma unroll
                for (int n = 0; n < 2; ++n) acc[a][b][m][n] = (f32x4){0.f, 0.f, 0.f, 0.f};
    bf16x8 At[4][2], B0[2][2], B1[2][2];
    const char* cA = (const char*)g.A + (size_t)cur.pm * tstep; const char* cB = (const char*)g.Bt + (size_t)cur.pn * tstep;
    S.a_ready(cur);
    if constexpr (SP2) {
        PG8_STAGE(PG8_SB(0, 0), cB, voffB); PG8_STAGE(PG8_SB(0, 1), cB + hstep, voffB); PG8_STAGE(PG8_SA(0, 0), cA, voffA); PG8_STAGE(PG8_SA(0, 1), cA + hstep, voffA);
        if (wr == 1) PG8_BAR;
        PG8_WAIT_V(2); PG8_BAR;
        PG8_STAGE(PG8_SB(1, 0), cB + kstep, voffB); PG8_STAGE(PG8_SA(1, 0), cA + kstep, voffA); PG8_STAGE(PG8_SB(1, 1), cB + hstep + kstep, voffB);
        PG8_WAIT_V(6); PG8_BAR;
    } else {
        PG8_STAGE(PG8_SB(0, 0), cB, voffB); PG8_STAGE(PG8_SA(0, 0), cA, voffA); PG8_STAGE(PG8_SB(0, 1), cB + hstep, voffB); PG8_STAGE(PG8_SA(0, 1), cA + hstep, voffA);
        if (wr == 1) PG8_BAR;
        PG8_WAIT_V(4); PG8_BAR;
        PG8_STAGE(PG8_SB(1, 0), cB + kstep, voffB); PG8_STAGE(PG8_SA(1, 0), cA + kstep, voffA); PG8_STAGE(PG8_SB(1, 1), cB + hstep + kstep, voffB);
        PG8_WAIT_V(6); PG8_BAR;
    }
    for (;;) {
        const bool has_next = S.next(ui + 1, nxt);
        const char* nA = has_next ? (const char*)g.A + (size_t)nxt.pm * tstep : cA; const char* nB = has_next ? (const char*)g.Bt + (size_t)nxt.pn * tstep : cB;
        for (int t = 0; t < nt; t += 2) {
            const bool last = (t == nt - 2);
            const char* a1 = cA + (size_t)(t + 1) * kstep;
            const char* a2 = last ? nA : cA + (size_t)(t + 2) * kstep; const char* b2 = last ? nB : cB + (size_t)(t + 2) * kstep;
            const char* a3 = a2 + kstep; const char* b3 = b2 + kstep;
            if (last && has_next) S.a_ready(nxt);
            if constexpr (SP2) {
            PG8_LDB(B0, 0, 0); PG8_LDB(B1, 0, 1); PG8_SCHED; PG8_LDA(At, 0, 0); PG8_STAGE(PG8_SA(1, 1), a1 + hstep, voffA);
            PG8_WAIT_V(8); PG8_WAIT_L(0); PG8_BAR; PG8_MMA(0, 0, At, B0); PG8_MMA(0, 1, At, B1); PG8_BAR; PG8_SCHED;
            PG8_LDA(At, 0, 1); PG8_STAGE(PG8_SB(0, 0), b2, voffB); PG8_STAGE(PG8_SB(0, 1), b2 + hstep, voffB); PG8_STAGE(PG8_SA(0, 0), a2, voffA);
            PG8_WAIT_V(8); PG8_WAIT_L(0); PG8_BAR; PG8_MMA(1, 0, At, B0); PG8_MMA(1, 1, At, B1); PG8_BAR; PG8_SCHED;
            PG8_LDB(B0, 1, 0); PG8_LDB(B1, 1, 1); PG8_SCHED; PG8_LDA(At, 1, 0); PG8_STAGE(PG8_SA(0, 1), a2 + hstep, voffA);
            PG8_WAIT_V(8); PG8_WAIT_L(0); PG8_BAR; PG8_MMA(0, 0, At, B0); PG8_MMA(0, 1, At, B1); PG8_BAR; PG8_SCHED;
            PG8_LDA(At, 1, 1); PG8_STAGE(PG8_SB(1, 0), b3, voffB); PG8_STAGE(PG8_SB(1, 1), b3 + hstep, voffB); PG8_STAGE(PG8_SA(1, 0), a3, voffA);
            PG8_WAIT_V(8); PG8_WAIT_L(0); PG8_BAR; PG8_MMA(1, 0, At, B0); PG8_MMA(1, 1, At, B1); PG8_BAR; PG8_SCHED;
            } else {
            PG8_LDB(B0, 0, 0); PG8_SCHED; PG8_LDA(At, 0, 0); PG8_STAGE(PG8_SA(1, 1), a1 + hstep, voffA);
            PG8_WAIT_L(8); PG8_BAR; PG8_WAIT_L(0); PG8_MMA(0, 0, At, B0); PG8_BAR; PG8_SCHED;
            PG8_LDB(B1, 0, 1); PG8_STAGE(PG8_SB(0, 0), b2, voffB);
            PG8_BAR; PG8_WAIT_L(0); PG8_MMA(0, 1, At, B1); PG8_BAR;
            PG8_LDA(At, 0, 1); PG8_STAGE(PG8_SA(0, 0), a2, voffA);
            PG8_BAR; PG8_WAIT_L(0); PG8_MMA(1, 0, At, B0); PG8_BAR; PG8_SCHED;
            PG8_STAGE(PG8_SB(0, 1), b2 + hstep, voffB);
            PG8_WAIT_V(6); PG8_BAR; PG8_MMA(1, 1, At, B1); PG8_BAR;
            PG8_LDB(B0, 1, 0); PG8_SCHED; PG8_LDA(At, 1, 0); PG8_STAGE(PG8_SA(0, 1), a2 + hstep, voffA);
            PG8_WAIT_L(8); PG8_BAR; PG8_WAIT_L(0); PG8_MMA(0, 0, At, B0); PG8_BAR; PG8_SCHED;
            PG8_LDB(B1, 1, 1); PG8_STAGE(PG8_SB(1, 0), b3, voffB);
            PG8_BAR; PG8_WAIT_L(0); PG8_MMA(0, 1, At, B1); PG8_BAR;
            PG8_LDA(At, 1, 1); PG8_STAGE(PG8_SA(1, 0), a3, voffA);
            PG8_BAR; PG8_WAIT_L(0); PG8_MMA(1, 0, At, B0); PG8_BAR; PG8_SCHED;
            PG8_STAGE(PG8_SB(1, 1), b3 + hstep, voffB);
            PG8_WAIT_V(6); PG8_BAR; PG8_MMA(1, 1, At, B1); PG8_BAR;
            }
        }
        if constexpr (ALIGN_EPI) { if (wr == 0) PG8_BAR; }
        if constexpr (!Epi::AFTER_DRAIN) { E(acc, cur, wr, wc, fr, fq); S.done(cur); }
        if (!has_next) break;
#pragma unroll
        for (int a = 0; a < 2; ++a)
#pragma unroll
            for (int b = 0; b < 2; ++b)
#pragma unroll
                for (int m = 0; m < 4; ++m)
#pragma unroll
                    for (int n = 0; n < 2; ++n) acc[a][b][m][n] = (f32x4){0.f, 0.f, 0.f, 0.f};
        cur = nxt; cA = nA; cB = nB; ++ui;
        if constexpr (ALIGN_EPI) { if (wr == 1) PG8_BAR; }
    }
    PG8_WAIT_V(0);
    if constexpr (!ALIGN_EPI) { if (wr == 0) PG8_BAR; }
    PG8_BAR;
    if constexpr (Epi::AFTER_DRAIN) { E.fused(acc, cur, wr, wc, fr, fq, lds, wid, lane); S.done(cur); }
#undef PG8_SA
#undef PG8_SB
#undef PG8_STAGE
#undef PG8_LDA
#undef PG8_LDB
#undef PG8_MMA
#undef PG8_WAIT_V
#undef PG8_WAIT_L
#undef PG8_BAR
#undef PG8_SCHED
}
}
namespace pg8 {
__device__ __forceinline__ float gelu_tanh1(float x) {
    const float z = x * (0.7978845608028654f + 0.035677408136300125f * x * x);
    const float t = __builtin_amdgcn_exp2f(-2.8853900817779268f * z);
    return x * __builtin_amdgcn_rcpf(1.0f + t);
}
constexpr float RMS_EPS = 1e-6f;
struct EpiGateIn {
    static constexpr bool PERM = true, AFTER_DRAIN = false;
    bf16_t* gate; bf16_t* xin; const float* ss;
    __device__ __forceinline__ void operator()(const f32x4 (&acc)[2][2][4][2], const Unit& u, int wr, int wc, int fr, int fq) const {
        const int row0 = u.pm * BM + wr * 64 + fr;
#pragma unroll
        for (int ai = 0; ai < 2; ++ai)
#pragma unroll
            for (int m = 0; m < 4; ++m) {
                const int row = row0 + ai * HALF + m * 16;
                const float rs = __builtin_amdgcn_rsqf(ss[row] * (1.0f / 1024.0f) + RMS_EPS);
#pragma unroll
                for (int bj = 0; bj < 2; ++bj) {
                    const int h128 = u.pn * 2 + bj; const bool isg = h128 < 11;
                    bf16_t* rowp = (isg ? gate : xin) + (size_t)row * 1408 + (isg ? h128 : h128 - 11) * 128 + wc * 32 + 8 * fq;
                    f32x4 v0 = acc[ai][bj][m][0] * rs, v1 = acc[ai][bj][m][1] * rs;
                    if (isg) {
#pragma unroll
                        for (int e = 0; e < 4; ++e) { v0[e] = gelu_tanh1(v0[e]); v1[e] = gelu_tanh1(v1[e]); }
                    }
                    u32x4 w; w.x = cvt_pk_bf16(v0[0], v0[1]); w.y = cvt_pk_bf16(v0[2], v0[3]); w.z = cvt_pk_bf16(v1[0], v1[1]); w.w = cvt_pk_bf16(v1[2], v1[3]);
                    *(u32x4*)rowp = w;
                }
            }
    }
};
struct EpiScaleBf16 {
    static constexpr bool PERM = true, AFTER_DRAIN = false;
    bf16_t* O; int ldc; const float* ss;
    __device__ __forceinline__ void operator()(const f32x4 (&acc)[2][2][4][2], const Unit& u, int wr, int wc, int fr, int fq) const {
        const int row0 = u.pm * BM + wr * 64 + fr, col0 = u.pn * BM + wc * 32 + 8 * fq;
#pragma unroll
        for (int ai = 0; ai < 2; ++ai)
#pragma unroll
            for (int m = 0; m < 4; ++m) {
                const int row = row0 + ai * HALF + m * 16;
                const float rs = __builtin_amdgcn_rsqf(ss[row] * (1.0f / 1024.0f) + RMS_EPS);
                bf16_t* rowp = O + (size_t)row * ldc + col0;
#pragma unroll
                for (int bj = 0; bj < 2; ++bj) {
                    const f32x4 v0 = acc[ai][bj][m][0] * rs, v1 = acc[ai][bj][m][1] * rs;
                    u32x4 w; w.x = cvt_pk_bf16(v0[0], v0[1]); w.y = cvt_pk_bf16(v0[2], v0[3]); w.z = cvt_pk_bf16(v1[0], v1[1]); w.w = cvt_pk_bf16(v1[2], v1[3]);
                    *(u32x4*)(rowp + bj * HALF) = w;
                }
            }
    }
};
struct EpiQKV {
    static constexpr bool PERM = true, AFTER_DRAIN = false;
    bf16_t* q; float* k; float* v; const float* ss;
    __device__ __forceinline__ void operator()(const f32x4 (&acc)[2][2][4][2], const Unit& u, int wr, int wc, int fr, int fq) const {
        const int row0 = u.pm * BM + wr * 64 + fr, cw = wc * 32 + 8 * fq;
#pragma unroll
        for (int ai = 0; ai < 2; ++ai)
#pragma unroll
            for (int m = 0; m < 4; ++m) {
                const int row = row0 + ai * HALF + m * 16;
                const float rs = __builtin_amdgcn_rsqf(ss[row] * (1.0f / 1024.0f) + RMS_EPS);
#pragma unroll
                for (int bj = 0; bj < 2; ++bj) {
                    const f32x4 v0 = acc[ai][bj][m][0] * rs, v1 = acc[ai][bj][m][1] * rs;
                    if (u.pn < 4) {
                        u32x4 w; w.x = cvt_pk_bf16(v0[0], v0[1]); w.y = cvt_pk_bf16(v0[2], v0[3]); w.z = cvt_pk_bf16(v1[0], v1[1]); w.w = cvt_pk_bf16(v1[2], v1[3]);
                        *(u32x4*)(q + (size_t)row * 1024 + u.pn * BM + bj * HALF + cw) = w;
                    } else {
                        float* p = (bj == 0 ? k : v) + (size_t)row * 128 + cw;
                        *(f32x4*)p = v0; *(f32x4*)(p + 4) = v1;
                    }
                }
            }
    }
};
template <bool WITH_HB> struct EpiResid {
    static constexpr bool PERM = false, AFTER_DRAIN = false;
    const float* base; float* out; bf16_t* hb; float* ssq;
    __device__ __forceinline__ void operator()(const f32x4 (&acc)[2][2][4][2], const Unit& u, int wr, int wc, int fr, int fq) const {
        typedef unsigned u32x2v __attribute__((ext_vector_type(2)));
        const int row0 = u.pm * BM + wr * 64 + fr, col0 = u.pn * BM + wc * 32 + 4 * fq;
#pragma unroll
        for (int ai = 0; ai < 2; ++ai)
#pragma unroll
            for (int m = 0; m < 4; ++m) {
                const int row = row0 + ai * HALF + m * 16; const size_t off = (size_t)row * 1024 + col0; float s = 0.f;
#pragma unroll
                for (int bj = 0; bj < 2; ++bj)
#pragma unroll
                    for (int n = 0; n < 2; ++n) {
                        const f32x4 b = *(const f32x4*)(base + off + bj * HALF + n * 16);
                        const f32x4 o = b + acc[ai][bj][m][n];
                        *(f32x4*)(out + off + bj * HALF + n * 16) = o;
                        if (WITH_HB) {
                            s += (o[0] * o[0] + o[1] * o[1]) + (o[2] * o[2] + o[3] * o[3]);
                            u32x2v w; w.x = cvt_pk_bf16(o[0], o[1]); w.y = cvt_pk_bf16(o[2], o[3]);
                            *(u32x2v*)(hb + off + bj * HALF + n * 16) = w;
                        }
                    }
                if (WITH_HB) {
                    s += __shfl_xor(s, 16); s += __shfl_xor(s, 32);
                    if (fq == 0) atomicAdd(ssq + row, s);
                }
            }
    }
};
}
#define GAS __attribute__((address_space(1)))
#define LAS __attribute__((address_space(3)))
typedef unsigned short bf16;
typedef unsigned v4u __attribute__((ext_vector_type(4)));
typedef float f32x4 __attribute__((ext_vector_type(4)));
typedef short bf16x8 __attribute__((ext_vector_type(8)));
typedef GAS unsigned gu32;
typedef GAS unsigned long long gu64;
#define RLX_AGENT __ATOMIC_RELAXED, __HIP_MEMORY_SCOPE_AGENT
#define LDS_WAIT() asm volatile("s_waitcnt lgkmcnt(0)" ::: "memory")
#define VM_WAIT() asm volatile("s_waitcnt vmcnt(0)" ::: "memory")
__device__ __forceinline__ unsigned long long rt() { return __builtin_amdgcn_s_memrealtime(); }
__device__ __forceinline__ unsigned f2bf(float f) { unsigned u = __builtin_bit_cast(unsigned, f); return (u + 0x7fffu + ((u >> 16) & 1u)) >> 16; }
__device__ __forceinline__ unsigned pk2(float lo, float hi) { return f2bf(lo) | (f2bf(hi) << 16); }

#define XB_TMO      128
#define XB_XCNT(j)  (256  + 64 * (j))
#define XB_XSUB(j)  (1280 + 64 * (j))
#define XB_XGEN(j)  (2304 + 64 * (j))
#define XB_TOP      3328
#define XB_TOPGEN   3392
#define XCD_BAR_WORDS 3456
#define XB_SPIN_CAP (1u << 18)

__device__ __forceinline__ unsigned xb_ld(unsigned* p)              { return __hip_atomic_load(p, __ATOMIC_RELAXED, __HIP_MEMORY_SCOPE_AGENT); }
__device__ __forceinline__ unsigned xb_add(unsigned* p, unsigned v) { return __hip_atomic_fetch_add(p, v, __ATOMIC_RELAXED, __HIP_MEMORY_SCOPE_AGENT); }
__device__ __forceinline__ unsigned xb_xcc_id() { return (unsigned)__builtin_amdgcn_s_getreg((3 << 11) | 20) & 0xFu; }
#define XB_SPIN(cond, bar) do { unsigned _sp = 0; while (cond) { __builtin_amdgcn_s_sleep(1); \
    if ((++_sp & 255u) == 0u) { if (xb_ld(&(bar)[XB_TMO])) break; if (_sp > XB_SPIN_CAP) { atomicAdd(&(bar)[XB_TMO], 1u); break; } } } } while (0)

struct XcdBarrier {
    unsigned* bar; unsigned x;
    volatile LAS unsigned* st;
};

__device__ __forceinline__ XcdBarrier xcd_barrier_post(unsigned* bar, volatile LAS unsigned* st, const int tid) {
    XcdBarrier b; b.bar = bar; b.x = xb_xcc_id(); b.st = st;
    if (tid == 0) (void)xb_add(&bar[XB_XCNT(b.x)], 1u);
    return b;
}
__device__ __forceinline__ void xcd_barrier_complete(unsigned* bar, unsigned x, unsigned& nloc, unsigned& nx) {
    const unsigned G = gridDim.x * gridDim.y * gridDim.z;
    unsigned sum, cnt, mine, sp = 0u;
    for (;;) {
        sum = 0u; cnt = 0u; mine = 0u;
#pragma unroll
        for (unsigned j = 0; j < 16; ++j) { const unsigned c = xb_ld(&bar[XB_XCNT(j)]); sum += c; cnt += (c > 0u) ? 1u : 0u; mine = (j == x) ? c : mine; }
        if (sum == G) break;
        __builtin_amdgcn_s_sleep(1);
        if ((++sp & 255u) == 0u) { if (xb_ld(&bar[XB_TMO])) break; if (sp > XB_SPIN_CAP) { atomicAdd(&bar[XB_TMO], 1u); break; } }
    }
    nloc = mine > 0u ? mine : 1u; nx = cnt > 0u ? cnt : 1u;
}

__device__ __forceinline__ void xcd_barrier(const XcdBarrier& b, const int tid) {
    asm volatile("s_waitcnt vmcnt(0)" ::: "memory");
    __syncthreads();
    if (tid == 0) {
        unsigned* bar = b.bar;
        __builtin_amdgcn_s_waitcnt(0);
        unsigned nloc = b.st[0], nx = b.st[1];
        if (nloc == 0u) { xcd_barrier_complete(bar, b.x, nloc, nx); b.st[0] = nloc; b.st[1] = nx; }
        const unsigned old = xb_add(&bar[XB_XSUB(b.x)], 1u);
        const unsigned gen = old / nloc;
        if (old + 1u == (gen + 1u) * nloc) {
            __builtin_amdgcn_fence(__ATOMIC_RELEASE, "agent");
            asm volatile("s_waitcnt vmcnt(0)" ::: "memory");
            const unsigned og = xb_add(&bar[XB_TOP], 1u);
            const unsigned tg = og / nx;
            if (og + 1u == (tg + 1u) * nx) xb_add(&bar[XB_TOPGEN], 1u);
            else XB_SPIN(xb_ld(&bar[XB_TOPGEN]) == tg, bar);
            __builtin_amdgcn_fence(__ATOMIC_ACQUIRE, "agent");
            xb_add(&bar[XB_XGEN(b.x)], 1u);
            asm volatile("s_waitcnt vmcnt(0)" ::: "memory");
        } else {
            XB_SPIN(xb_ld(&bar[XB_XGEN(b.x)]) == gen, bar);
            __builtin_amdgcn_fence(__ATOMIC_ACQUIRE, "agent");
            asm volatile("s_waitcnt vmcnt(0)" ::: "memory");
        }
    }
    __syncthreads();
}
constexpr int BATCH = 16, SEQ = 2048, D = 1024, M = BATCH * SEQ;
constexpr int LW = 1344, LWP = 1408, NBLK = 8, BDIM = 168;
constexpr int FF = 3072, FF2 = 6144, NH = 16, NKV = 2, HD = 64;
constexpr int N1 = 2 * LWP;
constexpr int NQKV = 1280;
enum { I_X = 0, I_POS, I_ANORM, I_WGATE, I_WIN, I_ACONVW, I_ACONVB, I_WRG, I_BRG, I_WIG, I_BIG, I_LAM, I_WOUT, I_KVNORM, I_WK, I_WV, I_KNORM, I_BNORM, I_WQ, I_QNORM, I_SINKS, I_WO, I_FNORM, I_WUP, I_FCONVW, I_FCONVB, I_WDOWN, N_IN };
constexpr size_t MiB = 1u << 20;
constexpr size_t WS_CTL = 0, CTL_ZERO_BYTES = 1 * MiB;
constexpr size_t WS_SSQ = 256 * 1024;
constexpr size_t WS_SS0 = 640 * 1024;
constexpr size_t WS_ROPE = 1 * MiB;
constexpr size_t WS_W1T = 4 * MiB, WS_WOUTT = 10 * MiB, WS_WUPT = 13 * MiB  , WS_WDOWNT = 37 * MiB  , WS_WQKVT = 49 * MiB, WS_WOT = 52 * MiB;
constexpr size_t WS_HB = 64 * MiB;
constexpr size_t WS_GATE = 128 * MiB, WS_XIN = 216 * MiB;
constexpr size_t WS_XR = 304 * MiB;
constexpr size_t WS_ACT = 128 * MiB;
constexpr size_t WS_UPH = 320 * MiB;
constexpr size_t WS_Q = 128 * MiB, WS_AO = 192 * MiB;
constexpr size_t WS_KRAW = 256 * MiB, WS_VRAW = 272 * MiB, WS_KN = 288 * MiB;
constexpr size_t WS_END = 512 * MiB;

__device__ __forceinline__ float bf2f(unsigned short h) { return __builtin_bit_cast(float, (unsigned)h << 16); }
__device__ __forceinline__ float gelu_tanh(float x) { const float z = x * (0.7978845608028654f + 0.035677408136300125f * x * x); return x / (1.0f + __expf(-2.0f * z)); }

constexpr int NWAVES = 8;
constexpr int RING_OFF = 0, RING_BYTES = 131072;
constexpr int LDSCTL_OFF = RING_BYTES, MISC_OFF = LDSCTL_OFF + 320;
constexpr int LDS_BYTES = 147456;
constexpr int NTHR = 512;
struct WtJob { const float* W; int Ksrc, Nsrc, ld; const float* g; bf16* Wt; int Nout, Kout, mode; };
__device__ __forceinline__ void p_wt(const WtJob& J, LAS unsigned char* lds, const int tid) {
    const int half = tid >> 8, t = tid & 255, tx = t & 31, ty = t >> 5;
    LAS float* tile = (LAS float*)(lds + half * 4352);
    const int nkt = J.Kout / 32, ntile = nkt * (J.Nout / 32);
    for (int it = blockIdx.x * 2; it < ntile; it += gridDim.x * 2) {
        const int tl = it + half, k0 = (tl % nkt) * 32, n0 = (tl / nkt) * 32;
#pragma unroll
        for (int j = 0; j < 4; ++j) {
            const int k = k0 + ty + 8 * j, n = n0 + tx;
            const int ns = J.mode == 2 ? (((n & 255) >> 7) ? 3072 : 0) + 128 * (n >> 8) + (n & 127) : n;
            float v = 0.f;
            if (k < J.Ksrc && ns < J.Nsrc) v = J.W[(size_t)k * J.ld + ns] * (J.g ? J.g[k] : 1.0f);
            tile[(ty + 8 * j) * 33 + tx] = v;
        }
        __syncthreads();
#pragma unroll
        for (int j = 0; j < 4; ++j) {
            const int n = n0 + ty + 8 * j, k = k0 + tx;
            J.Wt[(size_t)n * J.Kout + k] = (bf16)f2bf(tile[tx * 33 + ty + 8 * j]);
        }
        __syncthreads();
    }
}
__device__ __forceinline__ void p_xprep(const float* __restrict__ x, bf16* __restrict__ xb, float* __restrict__ ss0, const int tid) {
    const int lane = tid & 63;
    for (int row = blockIdx.x * NWAVES + (tid >> 6); row < M; row += gridDim.x * NWAVES) {
        const f32x4* xr = (const f32x4*)(x + (size_t)row * D) + lane;
        unsigned long long* o8 = (unsigned long long*)(xb + (size_t)row * D) + lane;
        float s = 0.f;
#pragma unroll
        for (int j = 0; j < 4; ++j) {
            const f32x4 v = xr[64 * j]; s += (v.x * v.x + v.y * v.y) + (v.z * v.z + v.w * v.w);
            o8[64 * j] = (unsigned long long)pk2(v.x, v.y) | ((unsigned long long)pk2(v.z, v.w) << 32);
        }
#pragma unroll
        for (int o = 1; o < 64; o <<= 1) s += __shfl_xor(s, o);
        if (lane == 0) ss0[row] = s;
    }
}
struct RopeFreq { float f[8]; };
__device__ __forceinline__ void p_rope(const int* __restrict__ pos, float* __restrict__ cs, const RopeFreq& rf, const int tid) {
    for (int idx = blockIdx.x * NTHR + tid; idx < M * 8; idx += gridDim.x * NTHR) {
        const int m = idx >> 3, i = idx & 7;
        const float ang = (float)pos[m] * rf.f[i];
        cs[(size_t)idx * 2] = cosf(ang); cs[(size_t)idx * 2 + 1] = sinf(ang);
    }
}
__device__ __forceinline__ void p_convffn(const bf16* __restrict__ uph, const float* __restrict__ cw, const float* __restrict__ cb, bf16* __restrict__ act, int mbase, const int tid) {
    for (size_t idx = (size_t)blockIdx.x * NTHR + tid; idx < (size_t)(M / 2) * FF; idx += (size_t)gridDim.x * NTHR) {
        const int mh = (int)(idx / FF), c = (int)(idx % FF), m = mbase + mh, t = m % SEQ;
        const int ng = (c >> 7) * 256 + (c & 127), nv = ng + 128;
        float g = cb[c], v = cb[FF + c];
#pragma unroll
        for (int k = 0; k < 3; ++k) if (t - 2 + k >= 0) { const size_t r = (size_t)(mh - 2 + k) * FF2; g += bf2f(uph[r + ng]) * cw[k * FF2 + c]; v += bf2f(uph[r + nv]) * cw[k * FF2 + FF + c]; }
        act[(size_t)m * FF + c] = (bf16)f2bf(gelu_tanh(g) * v);
    }
}
__device__ __forceinline__ void p_knorm(const float* __restrict__ kraw, const float* __restrict__ knorm, const float* __restrict__ cs, float* __restrict__ kn, const int tid) {
    for (int idx = blockIdx.x * NTHR + tid; idx < M * 2; idx += gridDim.x * NTHR) {
        const int m = idx >> 1, kvh = idx & 1;
        const float* kr = kraw + (size_t)m * 128 + kvh * 64; float kv[64]; float s = 0.f;
#pragma unroll
        for (int d = 0; d < 64; ++d) { kv[d] = kr[d]; s += kv[d] * kv[d]; }
        const float rs = rsqrtf(s * (1.0f / 64.0f) + 1e-6f);
#pragma unroll
        for (int d = 0; d < 64; ++d) kv[d] = kv[d] * rs * knorm[d];
        float* o = kn + (size_t)m * 128 + kvh * 64;
#pragma unroll
        for (int i = 0; i < 8; ++i) { const float c = cs[((size_t)m * 8 + i) * 2], sn = cs[((size_t)m * 8 + i) * 2 + 1]; const float x1 = kv[i], x2 = kv[8 + i]; o[i] = x1 * c - x2 * sn; o[8 + i] = x2 * c + x1 * sn; }
#pragma unroll
        for (int d = 16; d < 64; ++d) o[d] = kv[d];
    }
}
__device__ __forceinline__ void p_attn(const bf16* __restrict__ q, const float* __restrict__ kn, const float* __restrict__ vraw, const float* __restrict__ qnorm, const float* __restrict__ sinks,
                                       const float* __restrict__ cs, bf16* __restrict__ ao, const int tid) {
    for (int idx = blockIdx.x * NTHR + tid; idx < M * NH; idx += gridDim.x * NTHR) {
        const int m = idx >> 4, h = idx & 15, kvh = h >> 3, t = m % SEQ;
        float qv[64]; float s = 0.f;
#pragma unroll
        for (int d = 0; d < 64; ++d) { qv[d] = bf2f(q[(size_t)m * 1024 + h * 64 + d]); s += qv[d] * qv[d]; }
        const float rs = rsqrtf(s * (1.0f / 64.0f) + 1e-6f) * 0.125f;
#pragma unroll
        for (int d = 0; d < 64; ++d) qv[d] = qv[d] * rs * qnorm[d];
#pragma unroll
        for (int i = 0; i < 8; ++i) { const float c = cs[((size_t)m * 8 + i) * 2], sn = cs[((size_t)m * 8 + i) * 2 + 1]; const float x1 = qv[i], x2 = qv[8 + i]; qv[i] = x1 * c - x2 * sn; qv[8 + i] = x2 * c + x1 * sn; }
        float mx = sinks[h], l = 1.0f; float acc[64];
#pragma unroll
        for (int d = 0; d < 64; ++d) acc[d] = 0.f;
        const int klo = t - 127 < 0 ? 0 : t - 127;
        for (int kk = klo; kk <= t; ++kk) {
            const size_t mk = (size_t)(m - t + kk) * 128 + kvh * 64; float sc = 0.f;
#pragma unroll
            for (int d = 0; d < 64; ++d) sc += qv[d] * kn[mk + d];
            const float mn = fmaxf(mx, sc), f = __expf(mx - mn), p = __expf(sc - mn);
            l = l * f + p; mx = mn;
#pragma unroll
            for (int d = 0; d < 64; ++d) acc[d] = acc[d] * f + p * vraw[mk + d];
        }
        const float il = 1.0f / l;
#pragma unroll
        for (int d = 0; d < 64; ++d) ao[(size_t)m * 1024 + h * 64 + d] = (bf16)f2bf(acc[d] * il);
    }
}
constexpr int SC_T = 64, SC_AP = 416;
constexpr int SC_A = 0, SC_XRO = SC_A + SC_T * SC_AP, SC_AB = SC_XRO + SC_T * 168 * 4, SC_UB = SC_AB + SC_T * 96 * 4, SC_SEG = SC_UB + SC_T * 96 * 4, SC_CARRY = SC_SEG + 4 * 96 * 2 * 4, SC_END = SC_CARRY + 2 * 96 * 4;
static_assert(SC_END <= RING_BYTES, "scan phase LDS");
__device__ __forceinline__ void p_scan_fast(const bf16* __restrict__ xin, bf16* gate, const float* __restrict__ cw, const float* __restrict__ cb, const float* __restrict__ wrg, const float* __restrict__ brg,
                                            const float* __restrict__ wig, const float* __restrict__ big, const float* __restrict__ lam, LAS unsigned char* lds, const int tid) {
    const int lane = tid & 63, wid = __builtin_amdgcn_readfirstlane(tid >> 6);
    constexpr float LOG2E = 1.4426950408889634f;
    const int unit = blockIdx.x;
    if (unit < BATCH * NBLK * 2) {
        const int b = unit >> 4, hb = (unit >> 1) & 7, half = unit & 1;
        const int cbase = hb * BDIM, own0 = cbase + half * 84;
        for (int i = tid; i < SC_T * 12; i += NTHR) ((LAS unsigned*)(lds + SC_A + (i / 12) * SC_AP + 336))[i % 12] = 0u;
        if (tid < 96) ((LAS float*)(lds + SC_CARRY))[tid] = 0.f;
        const int o = tid % 21, s = tid / 21;
        float w1[4][8], cbv[8];
#pragma unroll
        for (int e = 0; e < 8; ++e) { cbv[e] = cb[cbase + o * 8 + e];
#pragma unroll
            for (int k = 0; k < 4; ++k) w1[k][e] = cw[k * LW + cbase + o * 8 + e]; }
        const int n = lane & 15, q = lane >> 4, j2 = wid * 16 + n; const bool v2 = (wid < 6) && (j2 < 84);
        pg8::bf16x8 Br[6], Bi[6];
#pragma unroll
        for (int ks = 0; ks < 6; ++ks) {
#pragma unroll
            for (int e = 0; e < 8; ++e) {
                const int k = ks * 32 + q * 8 + e; float a = 0.f, c = 0.f;
                const bool kok = v2 && (ks < 5 || q == 0);
                { const size_t off = ((size_t)(hb * BDIM + (kok ? k : 0))) * BDIM + half * 84 + (v2 ? j2 : 0); a = kok ? wrg[off] : 0.f; c = kok ? wig[off] : 0.f; }
                Br[ks][e] = (short)f2bf(a); Bi[ks][e] = (short)f2bf(c);
            }
            __builtin_amdgcn_sched_barrier(0);
        }
        float br2 = 0.f, bi2 = 0.f, lac = 0.f;
        if (v2) { br2 = brg[own0 + j2]; bi2 = big[own0 + j2]; const float lm = lam[own0 + j2]; lac = -8.0f * ((lm < 0.f ? -lm : 0.f) + log1pf(expf(-fabsf(lm)))); }
        const int seg = tid / 96, ch = tid % 96; const bool v3 = (tid < 384) && (ch < 84);
        LAS float* XRO = (LAS float*)(lds + SC_XRO); LAS float* AB = (LAS float*)(lds + SC_AB); LAS float* UB = (LAS float*)(lds + SC_UB);
        LAS float* SEGB = (LAS float*)(lds + SC_SEG); LAS float* CARRY = (LAS float*)(lds + SC_CARRY);
        for (int ck = 0; ck < SEQ / SC_T; ++ck) {
            const int t0 = ck * SC_T;
            if (tid < 504) {
#pragma unroll
                for (int r = 0; r < 3; ++r) {
                    const int tok = s + 24 * r;
                    if (tok < SC_T) {
                        const int t = t0 + tok; const size_t m = (size_t)b * SEQ + t;
                        float acc[8];
#pragma unroll
                        for (int e = 0; e < 8; ++e) acc[e] = cbv[e];
#pragma unroll
                        for (int k = 0; k < 4; ++k) {
                            {
                                const bool tok_ok = t - 3 + k >= 0;
                                v4u v = *(const v4u*)(xin + (tok_ok ? m - 3 + k : m) * LWP + cbase + o * 8);
                                if (!tok_ok) v = (v4u){0u, 0u, 0u, 0u};
                                acc[0] += w1[k][0] * __builtin_bit_cast(float, v.x << 16); acc[1] += w1[k][1] * __builtin_bit_cast(float, v.x & 0xffff0000u);
                                acc[2] += w1[k][2] * __builtin_bit_cast(float, v.y << 16); acc[3] += w1[k][3] * __builtin_bit_cast(float, v.y & 0xffff0000u);
                                acc[4] += w1[k][4] * __builtin_bit_cast(float, v.z << 16); acc[5] += w1[k][5] * __builtin_bit_cast(float, v.z & 0xffff0000u);
                                acc[6] += w1[k][6] * __builtin_bit_cast(float, v.w << 16); acc[7] += w1[k][7] * __builtin_bit_cast(float, v.w & 0xffff0000u);
                            }
                        }
                        v4u pk; pk.x = pk2(acc[0], acc[1]); pk.y = pk2(acc[2], acc[3]); pk.z = pk2(acc[4], acc[5]); pk.w = pk2(acc[6], acc[7]);
                        *(LAS v4u*)(lds + SC_A + tok * SC_AP + o * 16) = pk;
                        *(LAS f32x4*)(XRO + tok * 168 + o * 8) = (f32x4){acc[0], acc[1], acc[2], acc[3]}; *(LAS f32x4*)(XRO + tok * 168 + o * 8 + 4) = (f32x4){acc[4], acc[5], acc[6], acc[7]};
                    }
                }
            }
            __syncthreads();
            if (wid < 6) {
#pragma unroll
                for (int tt = 0; tt < 4; ++tt) {
                    f32x4 ar = {0.f, 0.f, 0.f, 0.f}, ai = {0.f, 0.f, 0.f, 0.f};
#pragma unroll
                    for (int ks = 0; ks < 6; ++ks) {
                        const pg8::bf16x8 af = *(const LAS pg8::bf16x8*)(lds + SC_A + (tt * 16 + n) * SC_AP + ks * 64 + q * 16);
                        ar = __builtin_amdgcn_mfma_f32_16x16x32_bf16(af, Br[ks], ar, 0, 0, 0);
                        ai = __builtin_amdgcn_mfma_f32_16x16x32_bf16(af, Bi[ks], ai, 0, 0, 0);
                    }
#pragma unroll
                    for (int rg = 0; rg < 4; ++rg) {
                        const int tok = tt * 16 + q * 4 + rg;
                        const float zr = ar[rg] + br2, zi = ai[rg] + bi2;
                        const float r = __builtin_amdgcn_rcpf(1.0f + __builtin_amdgcn_exp2f(-LOG2E * zr)), ig = __builtin_amdgcn_rcpf(1.0f + __builtin_amdgcn_exp2f(-LOG2E * zi));
                        const float la = r * lac, a = __builtin_amdgcn_exp2f(LOG2E * la), x2 = 2.0f * la;
                        const float m2s = -(x2 * (1.0f + x2 * (0.5f + x2 * (0.16666667f + x2 * (0.041666668f + x2 * 0.008333334f)))));
                        const float m2 = x2 > -0.25f ? m2s : 1.0f - a * a;
                        const float mult = __builtin_amdgcn_sqrtf(m2);
                        const float xv = XRO[tok * 168 + half * 84 + (v2 ? j2 : 0)];
                        AB[tok * 96 + j2] = a; UB[tok * 96 + j2] = v2 ? mult * ig * xv : 0.f;
                    }
                }
            }
            __syncthreads();
            float hl[16], pl[16];
            if (tid < 384) {
                float h = 0.f, P = 1.f;
#pragma unroll
                for (int k = 0; k < 16; ++k) { const int tok = seg * 16 + k; const float a = AB[tok * 96 + ch], u = UB[tok * 96 + ch]; h = a * h + u; P *= a; hl[k] = h; pl[k] = P; }
                SEGB[(seg * 96 + ch) * 2] = P; SEGB[(seg * 96 + ch) * 2 + 1] = h;
            }
            __syncthreads();
            if (tid < 384) {
                float c = CARRY[(ck & 1) * 96 + ch];
                if (seg > 0) c = SEGB[(0 * 96 + ch) * 2] * c + SEGB[(0 * 96 + ch) * 2 + 1];
                if (seg > 1) c = SEGB[(1 * 96 + ch) * 2] * c + SEGB[(1 * 96 + ch) * 2 + 1];
                if (seg > 2) c = SEGB[(2 * 96 + ch) * 2] * c + SEGB[(2 * 96 + ch) * 2 + 1];
                if (seg == 3) CARRY[((ck + 1) & 1) * 96 + ch] = pl[15] * c + hl[15];
                if (v3) {
                    bf16* gp = gate + ((size_t)b * SEQ + t0 + seg * 16) * LWP + own0 + ch;
#pragma unroll
                    for (int k = 0; k < 16; ++k) { const float y = bf2f(gp[(size_t)k * LWP]) * (hl[k] + pl[k] * c); gp[(size_t)k * LWP] = (bf16)f2bf(y); }
                }
            }
        }
        __syncthreads();
    }
}
constexpr int CW_BAR = 4096;
struct Args { const void* in[N_IN]; float* out; unsigned char* ws; RopeFreq rf; };

__global__ void __launch_bounds__(NWAVES * 64, 2) skel_fwd(Args args) {
    extern __shared__ __attribute__((aligned(16))) unsigned char lds[];
    LAS unsigned char* L = (LAS unsigned char*)lds;
    volatile LAS unsigned* MISC = (volatile LAS unsigned*)(L + MISC_OFF);
    unsigned char* ws = args.ws;
    const int G = gridDim.x;
    const int wid_s = __builtin_amdgcn_readfirstlane((int)threadIdx.x >> 6);
#define TID() pg8_fresh_tid(wid_s)
    for (int u = TID(); u < (LDS_BYTES - LDSCTL_OFF) / 4; u += NWAVES * 64) ((LAS unsigned*)(L + LDSCTL_OFF))[u] = 0u;
    __syncthreads();
    XcdBarrier bar = xcd_barrier_post((unsigned*)(ws + WS_CTL) + CW_BAR, MISC + 8, TID());
#define GRID_BAR() xcd_barrier(bar, TID())
#define FIN(i) ((const float*)args.in[i])
    const float* x = FIN(I_X);
    float* ssq = (float*)(ws + WS_SSQ);
    float* ss0 = (float*)(ws + WS_SS0);
    bf16* HB = (bf16*)(ws + WS_HB);
    const float* cs = (const float*)(ws + WS_ROPE);

    {
        const int ptid = TID();
        { WtJob J{FIN(I_WGATE), D, LW, LW, FIN(I_ANORM), (bf16*)(ws + WS_W1T), LWP, D, 0}; p_wt(J, L, ptid); }
        { WtJob J{FIN(I_WIN), D, LW, LW, FIN(I_ANORM), (bf16*)(ws + WS_W1T) + (size_t)LWP * D, LWP, D, 0}; p_wt(J, L, ptid); }
        { WtJob J{FIN(I_WOUT), LW, D, D, nullptr, (bf16*)(ws + WS_WOUTT), D, LWP, 0}; p_wt(J, L, ptid); }
#pragma unroll
        for (int l = 0; l < 2; ++l) {
            { WtJob J{FIN(I_WUP) + (size_t)l * D * FF2, D, FF2, FF2, FIN(I_FNORM) + l * D, (bf16*)(ws + WS_WUPT) + (size_t)l * FF2 * D, FF2, D, 2}; p_wt(J, L, ptid); }
            { WtJob J{FIN(I_WDOWN) + (size_t)l * FF * D, FF, D, D, nullptr, (bf16*)(ws + WS_WDOWNT) + (size_t)l * D * FF, D, FF, 0}; p_wt(J, L, ptid); }
        }
        { WtJob J{FIN(I_WQ), D, 1024, 1024, FIN(I_BNORM), (bf16*)(ws + WS_WQKVT), 1024, D, 0}; p_wt(J, L, ptid); }
        { WtJob J{FIN(I_WK), D, 128, 128, FIN(I_KVNORM), (bf16*)(ws + WS_WQKVT) + (size_t)1024 * D, 128, D, 0}; p_wt(J, L, ptid); }
        { WtJob J{FIN(I_WV), D, 128, 128, FIN(I_KVNORM), (bf16*)(ws + WS_WQKVT) + (size_t)1152 * D, 128, D, 0}; p_wt(J, L, ptid); }
        { WtJob J{FIN(I_WO), D, D, D, nullptr, (bf16*)(ws + WS_WOT), D, D, 0}; p_wt(J, L, ptid); }
        p_xprep(x, HB, ss0, ptid);
        p_rope((const int*)args.in[I_POS], (float*)(ws + WS_ROPE), args.rf, ptid);
    }
    GRID_BAR();
    {
        pg8::Gemm g{HB, (const bf16*)(ws + WS_W1T), M, N1, D}; pg8::StaticOrder S; S.init(M, N1, G, (int)blockIdx.x);
        pg8::EpiGateIn E{(bf16*)(ws + WS_GATE), (bf16*)(ws + WS_XIN), ss0};
        pg8::gemm_phase<pg8::EpiGateIn, pg8::StaticOrder, true, true>(L + RING_OFF, g, S, E, wid_s);
    }
    GRID_BAR();
    p_scan_fast((const bf16*)(ws + WS_XIN), (bf16*)(ws + WS_GATE), FIN(I_ACONVW), FIN(I_ACONVB), FIN(I_WRG), FIN(I_BRG), FIN(I_WIG), FIN(I_BIG), FIN(I_LAM), L + RING_OFF, TID());
    GRID_BAR();
    {
        pg8::Gemm g{(const bf16*)(ws + WS_GATE), (const bf16*)(ws + WS_WOUTT), M, D, LWP}; pg8::StaticOrder S; S.init(M, D, G, (int)blockIdx.x);
        pg8::EpiResid<true> E{x, args.out, HB, ssq};
        pg8::gemm_phase<pg8::EpiResid<true>, pg8::StaticOrder, true, true>(L + RING_OFF, g, S, E, wid_s);
    }
    GRID_BAR();
#define FFN_UP_HALF(l, half) do { \
        { pg8::Gemm g{HB + (size_t)(half) * (M / 2) * D, (const bf16*)(ws + WS_WUPT) + (size_t)(l) * FF2 * D, M / 2, FF2, D}; pg8::StaticOrder S; S.init(M / 2, FF2, G, (int)blockIdx.x); \
          pg8::EpiScaleBf16 E{(bf16*)(ws + WS_UPH), FF2, ssq + (size_t)((l) == 0 ? 0 : 2) * M + (size_t)(half) * (M / 2)}; \
          pg8::gemm_phase<pg8::EpiScaleBf16, pg8::StaticOrder, true, true>(L + RING_OFF, g, S, E, wid_s); } \
        GRID_BAR(); \
        p_convffn((const bf16*)(ws + WS_UPH), FIN(I_FCONVW) + (size_t)(l) * 3 * FF2, FIN(I_FCONVB) + (size_t)(l) * FF2, (bf16*)(ws + WS_ACT), (half) * (M / 2), TID()); \
        GRID_BAR(); } while (0)
    FFN_UP_HALF(0, 0); FFN_UP_HALF(0, 1);
    {
        pg8::Gemm g{(const bf16*)(ws + WS_ACT), (const bf16*)(ws + WS_WDOWNT), M, D, FF}; pg8::StaticOrder S; S.init(M, D, G, (int)blockIdx.x);
        pg8::EpiResid<true> E{args.out, args.out, HB, ssq + M};
        pg8::gemm_phase<pg8::EpiResid<true>, pg8::StaticOrder, true, true>(L + RING_OFF, g, S, E, wid_s);
    }
    GRID_BAR();
    {
        pg8::Gemm g{HB, (const bf16*)(ws + WS_WQKVT), M, NQKV, D}; pg8::StaticOrder S; S.init(M, NQKV, G, (int)blockIdx.x);
        pg8::EpiQKV E{(bf16*)(ws + WS_Q), (float*)(ws + WS_KRAW), (float*)(ws + WS_VRAW), ssq + M};
        pg8::gemm_phase<pg8::EpiQKV, pg8::StaticOrder, true, true>(L + RING_OFF, g, S, E, wid_s);
    }
    GRID_BAR();
    p_knorm((const float*)(ws + WS_KRAW), FIN(I_KNORM), cs, (float*)(ws + WS_KN), TID());
    GRID_BAR();
    p_attn((const bf16*)(ws + WS_Q), (const float*)(ws + WS_KN), (const float*)(ws + WS_VRAW), FIN(I_QNORM), FIN(I_SINKS), cs, (bf16*)(ws + WS_AO), TID());
    GRID_BAR();
    {
        pg8::Gemm g{(const bf16*)(ws + WS_AO), (const bf16*)(ws + WS_WOT), M, D, D}; pg8::StaticOrder S; S.init(M, D, G, (int)blockIdx.x);
        pg8::EpiResid<true> E{args.out, args.out, HB, ssq + 2 * (size_t)M};
        pg8::gemm_phase<pg8::EpiResid<true>, pg8::StaticOrder, true, true>(L + RING_OFF, g, S, E, wid_s);
    }
    GRID_BAR();
    FFN_UP_HALF(1, 0); FFN_UP_HALF(1, 1);
    {
        pg8::Gemm g{(const bf16*)(ws + WS_ACT), (const bf16*)(ws + WS_WDOWNT) + (size_t)D * FF, M, D, FF}; pg8::StaticOrder S; S.init(M, D, G, (int)blockIdx.x);
        pg8::EpiResid<false> E{args.out, args.out, nullptr, nullptr};
        pg8::gemm_phase<pg8::EpiResid<false>, pg8::StaticOrder, true, true>(L + RING_OFF, g, S, E, wid_s);
    }
#undef FFN_UP_HALF
#undef GRID_BAR
#undef FIN
}

extern "C" void kernel_launch(void* const* d_in, const int* in_sizes, int n_in, void* d_out, int out_size, void* d_ws, size_t ws_size, hipStream_t stream) {
    static int grid = 0;
    if (grid == 0) {
        if (n_in != N_IN || in_sizes[0] != M * D || out_size != M * D || ws_size < WS_END) { fprintf(stderr, "kernel_launch: shape/workspace mismatch (n_in %d, in0 %d, out %d, ws %zu)\n", n_in, n_in > 0 ? in_sizes[0] : -1, out_size, ws_size); grid = -1; return; }
        int dev = 0, cus = 0, per_cu = 0;
        if (hipGetDevice(&dev) != hipSuccess || hipDeviceGetAttribute(&cus, hipDeviceAttributeMultiprocessorCount, dev) != hipSuccess) { grid = -1; return; }
        if (hipFuncSetAttribute((const void*)skel_fwd, hipFuncAttributeMaxDynamicSharedMemorySize, LDS_BYTES) != hipSuccess) { fprintf(stderr, "kernel_launch: hipFuncSetAttribute failed\n"); grid = -1; return; }
        if (hipOccupancyMaxActiveBlocksPerMultiprocessor(&per_cu, (const void*)skel_fwd, NWAVES * 64, LDS_BYTES) != hipSuccess || per_cu < 1)
            fprintf(stderr, "kernel_launch: note: occupancy query reports %d workgroups per CU\n", per_cu);
        (void)hipGetLastError();
        grid = cus;
    }
    if (grid < 0) return;
    unsigned char* ws = (unsigned char*)d_ws;
    (void)hipMemsetAsync(ws + WS_CTL, 0, CTL_ZERO_BYTES, stream);
    Args a{};
    for (int i = 0; i < N_IN; ++i) a.in[i] = d_in[i];
    a.out = (float*)d_out; a.ws = ws;
    for (int i = 0; i < 8; ++i) a.rf.f[i] = (float)pow(500000.0, -(double)i / 8.0);
    hipLaunchKernelGGL(skel_fwd, dim3(grid), dim3(NWAVES * 64), LDS_BYTES, stream, a);
}
```

```cpp
#include <hip/hip_runtime.h>
#include <cstdio>
#include <cstdint>
__device__ __forceinline__ int pg8_fresh_tid(int wid_s) {
    int l; asm volatile("v_mbcnt_lo_u32_b32 %0, -1, 0\n\tv_mbcnt_hi_u32_b32 %0, -1, %0" : "=v"(l));
    return wid_s * 64 + l;
}
namespace pg8 {
#define PG8_LAS __attribute__((address_space(3)))
typedef unsigned short bf16_t;
typedef short bf16x8 __attribute__((ext_vector_type(8)));
typedef float f32x4 __attribute__((ext_vector_type(4)));
typedef unsigned u32x4 __attribute__((ext_vector_type(4)));
constexpr int BM = 256, BK = 64, HALF = 128, HTB = HALF * BK * 2  , STAGE_BYTES = 8 * HTB, NXCD = 8, WGM = 8;

__host__ __device__ __forceinline__ int lds_byte(int r, int c) { const int st = (r >> 4) * 2 + (c >> 5), rr = r & 15, cc = c & 31, ob = rr * 64 + cc * 2; return st * 1024 + (ob ^ (((ob >> 9) & 1) << 5)); }
__host__ __device__ __forceinline__ void stage_rc(int b, int& R, int& C) { const int st = b / 1024, sb = b % 1024, swz = sb ^ (((sb >> 9) & 1) << 5); R = (st >> 1) * 16 + swz / 64; C = (st & 1) * 32 + (swz % 64) / 2; }
__host__ __device__ __forceinline__ int perm32(int rho) { const int n = rho >> 4, i = rho & 15; return 8 * (i >> 2) + 4 * n + (i & 3); }

struct Unit { int pm, pn; };
struct Gemm { const bf16_t* A; const bf16_t* Bt; int M, N, K; };

struct StaticOrder {
    int nM, nN, nwg, G, c;
    __host__ __device__ void init(int M, int N, int G_, int c_) { nM = M / BM; nN = N / BM; nwg = nM * nN; G = G_; c = c_; }
    __host__ __device__ bool next(int i, Unit& u) const {
        const long L = (long)i * G + c; if (L >= nwg) return false;
        int wgid = (int)L; { const int q = nwg / NXCD, r = nwg % NXCD, xcd = wgid % NXCD, off = wgid / NXCD; wgid = (xcd < r ? xcd * (q + 1) : r * (q + 1) + (xcd - r) * q) + off; }
        const int nig = WGM * nN, gid = wgid / nig, fm = gid * WGM, gsz = (nM - fm) < WGM ? (nM - fm) : WGM;
        u.pm = fm + ((wgid % nig) % gsz); u.pn = (wgid % nig) / gsz; return true;
    }
    __device__ __forceinline__ void a_ready(const Unit&) const {}
    __device__ __forceinline__ void done(const Unit&) const {}
};

__device__ __forceinline__ unsigned cvt_pk_bf16(float lo, float hi) { unsigned r; asm volatile("v_cvt_pk_bf16_f32 %0, %1, %2" : "=v"(r) : "v"(lo), "v"(hi)); return r; }
typedef float f32x2 __attribute__((ext_vector_type(2)));
__device__ __forceinline__ f32x2 gelu_pk(f32x2 v) {
    const f32x2 av = __builtin_elementwise_abs(v), d = av * 0.2316418882f + 1.0f;
    f32x2 t; t.x = __builtin_amdgcn_rcpf(d.x); t.y = __builtin_amdgcn_rcpf(d.y);
    f32x2 q = t * 0.5307027145f + (-0.7265760135f); q = q * t + 0.7107068705f; q = q * t + (-0.142248368f); q = q * t + 0.127414796f; q = q * t;
    const f32x2 s = (v * v) * (-0.72134752044f);
    f32x2 e; e.x = __builtin_amdgcn_exp2f(s.x); e.y = __builtin_amdgcn_exp2f(s.y);
    const f32x2 m = v * (q * e), r = v - m;
    f32x2 o; o.x = v.x < 0.f ? m.x : r.x; o.y = v.y < 0.f ? m.y : r.y; return o;
}

template <int ACT  > struct EpiBf16 {
    static constexpr bool PERM = true, AFTER_DRAIN = false; static_assert(ACT == 0 || ACT == 1, "EpiBf16: ACT is 0 (none) or 1 (gelu_pk)");
    bf16_t* O; int ldc; const float* bias; int split_cols; size_t split_stride; float scale0;
    __device__ __forceinline__ void operator()(const f32x4 (&acc)[2][2][4][2], const Unit& u, int wr, int wc, int fr, int fq) const {
        const int row0 = u.pm * BM + wr * 64 + fr; int colt = u.pn * BM; bf16_t* base = O;
        float sc = 1.f; if (split_cols) { const int t = colt / split_cols; base += (size_t)t * split_stride; colt -= t * split_cols; if (t == 0) sc = scale0; }
        const int col0 = colt + wc * 32 + 8 * fq, bcol0 = u.pn * BM + wc * 32 + 8 * fq;
        f32x4 bv[2][2];
#pragma unroll
        for (int bj = 0; bj < 2; ++bj)
#pragma unroll
            for (int n = 0; n < 2; ++n) bv[bj][n] = bias ? *(const f32x4*)(bias + bcol0 + bj * HALF + 4 * n) : (f32x4){0.f, 0.f, 0.f, 0.f};
#pragma unroll
        for (int ai = 0; ai < 2; ++ai)
#pragma unroll
            for (int m = 0; m < 4; ++m) { bf16_t* rowp = base + (size_t)(row0 + ai * HALF + m * 16) * ldc + col0;
#pragma unroll
                for (int bj = 0; bj < 2; ++bj) { f32x4 v0 = acc[ai][bj][m][0] + bv[bj][0], v1 = acc[ai][bj][m][1] + bv[bj][1];
                    if (ACT == 1) { f32x2 a = gelu_pk((f32x2){v0[0], v0[1]}), b = gelu_pk((f32x2){v0[2], v0[3]}), c = gelu_pk((f32x2){v1[0], v1[1]}), d = gelu_pk((f32x2){v1[2], v1[3]});
                        v0 = (f32x4){a.x, a.y, b.x, b.y}; v1 = (f32x4){c.x, c.y, d.x, d.y}; }
                    v0 = v0 * sc; v1 = v1 * sc; u32x4 w; w.x = cvt_pk_bf16(v0[0], v0[1]); w.y = cvt_pk_bf16(v0[2], v0[3]); w.z = cvt_pk_bf16(v1[0], v1[1]); w.w = cvt_pk_bf16(v1[2], v1[3]);
                    *(u32x4*)(rowp + bj * HALF) = w; } }
    }
};
template <class Epi, class Sched, bool ALIGN_EPI = false, bool SP2 = false>
__device__ __forceinline__ void gemm_phase(PG8_LAS unsigned char* lds, const Gemm g, const Sched& S, const Epi& E, const int wid_s) {
    const int tid = pg8_fresh_tid(wid_s),
        wid = __builtin_amdgcn_readfirstlane(tid >> 6), lane = tid & 63, wr = wid >> 2, wc = wid & 3, fr = lane & 15, fq = lane >> 4;
    const int K = g.K, nt = K / BK;
    unsigned voffA[2], voffB[2];
#pragma unroll
    for (int i = 0; i < 2; ++i) { int R, C; stage_rc(tid * 16 + i * 8192, R, C); const int Rb = Epi::PERM ? ((R & ~31) + perm32(R & 31)) : R;
        voffA[i] = (unsigned)(R * K + C) * 2u; voffB[i] = (unsigned)(Rb * K + C) * 2u; }
    const size_t kstep = (size_t)(BK * 2);
    const size_t hstep = (size_t)HALF * K * 2;
    const size_t tstep = 2 * hstep;
    const unsigned ldsw = (unsigned)wid * 1024u;
    const int aoff = lds_byte(wr * 64 + fr, fq * 8), boff = lds_byte(wc * 32 + fr, fq * 8);
#define PG8_SA(b, h) (((b) * 2 + (h)) * HTB)
#define PG8_SB(b, h) ((4 + (b) * 2 + (h)) * HTB)
#define PG8_STAGE(bufoff, gbase, voff) do { _Pragma("unroll") for (int _i = 0; _i < 2; ++_i) \
        __builtin_amdgcn_global_load_lds((const unsigned*)((const char*)(gbase) + (voff)[_i]), (PG8_LAS unsigned*)(lds + (bufoff) + ldsw + _i * 8192), 16, 0, 0); } while (0)
#define PG8_LDA(dst, b, h) do { _Pragma("unroll") for (int m = 0; m < 4; ++m) _Pragma("unroll") for (int k = 0; k < 2; ++k) dst[m][k] = *(const PG8_LAS bf16x8*)(lds + PG8_SA(b, h) + aoff + m * 2048 + k * 1024); } while (0)
#define PG8_LDB(dst, b, h) do { _Pragma("unroll") for (int n = 0; n < 2; ++n) _Pragma("unroll") for (int k = 0; k < 2; ++k) dst[n][k] = *(const PG8_LAS bf16x8*)(lds + PG8_SB(b, h) + boff + n * 2048 + k * 1024); } while (0)
#define PG8_MMA(ai, bj, At, Bt) do { __builtin_amdgcn_s_setprio(1); _Pragma("unroll") for (int m = 0; m < 4; ++m) _Pragma("unroll") for (int n = 0; n < 2; ++n) _Pragma("unroll") for (int k = 0; k < 2; ++k) \
        acc[ai][bj][m][n] = __builtin_amdgcn_mfma_f32_16x16x32_bf16(Bt[n][k], At[m][k], acc[ai][bj][m][n], 0, 0, 0); __builtin_amdgcn_s_setprio(0); } while (0)
#define PG8_WAIT_V(n) asm volatile("s_waitcnt vmcnt(" #n ")" ::: "memory")
#define PG8_WAIT_L(n) asm volatile("s_waitcnt lgkmcnt(" #n ")" ::: "memory")
#define PG8_BAR __builtin_amdgcn_s_barrier()
#define PG8_SCHED __builtin_amdgcn_sched_barrier(0)
    Unit cur, nxt; int ui = 0;
    if (!S.next(0, cur)) return;
    f32x4 acc[2][2][4][2];
#pragma unroll
    for (int a = 0; a < 2; ++a)
#pragma unroll
        for (int b = 0; b < 2; ++b)
#pragma unroll
            for (int m = 0; m < 4; ++m)
#pragma unroll
                for (int n = 0; n < 2; ++n) acc[a][b][m][n] = (f32x4){0.f, 0.f, 0.f, 0.f};
    bf16x8 At[4][2], B0[2][2], B1[2][2];
    const char* cA = (const char*)g.A + (size_t)cur.pm * tstep; const char* cB = (const char*)g.Bt + (size_t)cur.pn * tstep;
    S.a_ready(cur);
    if constexpr (SP2) {
        PG8_STAGE(PG8_SB(0, 0), cB, voffB); PG8_STAGE(PG8_SB(0, 1), cB + hstep, voffB); PG8_STAGE(PG8_SA(0, 0), cA, voffA); PG8_STAGE(PG8_SA(0, 1), cA + hstep, voffA);
        if (wr == 1) PG8_BAR;
        PG8_WAIT_V(2); PG8_BAR;
        PG8_STAGE(PG8_SB(1, 0), cB + kstep, voffB); PG8_STAGE(PG8_SA(1, 0), cA + kstep, voffA); PG8_STAGE(PG8_SB(1, 1), cB + hstep + kstep, voffB);
        PG8_WAIT_V(6); PG8_BAR;
    } else {
        PG8_STAGE(PG8_SB(0, 0), cB, voffB); PG8_STAGE(PG8_SA(0, 0), cA, voffA); PG8_STAGE(PG8_SB(0, 1), cB + hstep, voffB); PG8_STAGE(PG8_SA(0, 1), cA + hstep, voffA);
        if (wr == 1) PG8_BAR;
        PG8_WAIT_V(4); PG8_BAR;
        PG8_STAGE(PG8_SB(1, 0), cB + kstep, voffB); PG8_STAGE(PG8_SA(1, 0), cA + kstep, voffA); PG8_STAGE(PG8_SB(1, 1), cB + hstep + kstep, voffB);
        PG8_WAIT_V(6); PG8_BAR;
    }
    for (;;) {
        const bool has_next = S.next(ui + 1, nxt);
        const char* nA = has_next ? (const char*)g.A + (size_t)nxt.pm * tstep : cA; const char* nB = has_next ? (const char*)g.Bt + (size_t)nxt.pn * tstep : cB;
        for (int t = 0; t < nt; t += 2) {
            const bool last = (t == nt - 2);
            const char* a1 = cA + (size_t)(t + 1) * kstep;
            const char* a2 = last ? nA : cA + (size_t)(t + 2) * kstep; const char* b2 = last ? nB : cB + (size_t)(t + 2) * kstep;
            const char* a3 = a2 + kstep; const char* b3 = b2 + kstep;
            if (last && has_next) S.a_ready(nxt);
            if constexpr (SP2) {
            PG8_LDB(B0, 0, 0); PG8_LDB(B1, 0, 1); PG8_SCHED; PG8_LDA(At, 0, 0); PG8_STAGE(PG8_SA(1, 1), a1 + hstep, voffA);
            PG8_WAIT_V(8); PG8_WAIT_L(0); PG8_BAR; PG8_MMA(0, 0, At, B0); PG8_MMA(0, 1, At, B1); PG8_BAR; PG8_SCHED;
            PG8_LDA(At, 0, 1); PG8_STAGE(PG8_SB(0, 0), b2, voffB); PG8_STAGE(PG8_SB(0, 1), b2 + hstep, voffB); PG8_STAGE(PG8_SA(0, 0), a2, voffA);
            PG8_WAIT_V(8); PG8_WAIT_L(0); PG8_BAR; PG8_MMA(1, 0, At, B0); PG8_MMA(1, 1, At, B1); PG8_BAR; PG8_SCHED;
            PG8_LDB(B0, 1, 0); PG8_LDB(B1, 1, 1); PG8_SCHED; PG8_LDA(At, 1, 0); PG8_STAGE(PG8_SA(0, 1), a2 + hstep, voffA);
            PG8_WAIT_V(8); PG8_WAIT_L(0); PG8_BAR; PG8_MMA(0, 0, At, B0); PG8_MMA(0, 1, At, B1); PG8_BAR; PG8_SCHED;
            PG8_LDA(At, 1, 1); PG8_STAGE(PG8_SB(1, 0), b3, voffB); PG8_STAGE(PG8_SB(1, 1), b3 + hstep, voffB); PG8_STAGE(PG8_SA(1, 0), a3, voffA);
            PG8_WAIT_V(8); PG8_WAIT_L(0); PG8_BAR; PG8_MMA(1, 0, At, B0); PG8_MMA(1, 1, At, B1); PG8_BAR; PG8_SCHED;
            } else {
            PG8_LDB(B0, 0, 0); PG8_SCHED; PG8_LDA(At, 0, 0); PG8_STAGE(PG8_SA(1, 1), a1 + hstep, voffA);
            PG8_WAIT_L(8); PG8_BAR; PG8_WAIT_L(0); PG8_MMA(0, 0, At, B0); PG8_BAR; PG8_SCHED;
            PG8_LDB(B1, 0, 1); PG8_STAGE(PG8_SB(0, 0), b2, voffB);
            PG8_BAR; PG8_WAIT_L(0); PG8_MMA(0, 1, At, B1); PG8_BAR;
            PG8_LDA(At, 0, 1); PG8_STAGE(PG8_SA(0, 0), a2, voffA);
            PG8_BAR; PG8_WAIT_L(0); PG8_MMA(1, 0, At, B0); PG8_BAR; PG8_SCHED;
            PG8_STAGE(PG8_SB(0, 1), b2 + hstep, voffB);
            PG8_WAIT_V(6); PG8_BAR; PG8_MMA(1, 1, At, B1); PG8_BAR;
            PG8_LDB(B0, 1, 0); PG8_SCHED; PG8_LDA(At, 1, 0); PG8_STAGE(PG8_SA(0, 1), a2 + hstep, voffA);
            PG8_WAIT_L(8); PG8_BAR; PG8_WAIT_L(0); PG8_MMA(0, 0, At, B0); PG8_BAR; PG8_SCHED;
            PG8_LDB(B1, 1, 1); PG8_STAGE(PG8_SB(1, 0), b3, voffB);
            PG8_BAR; PG8_WAIT_L(0); PG8_MMA(0, 1, At, B1); PG8_BAR;
            PG8_LDA(At, 1, 1); PG8_STAGE(PG8_SA(1, 0), a3, voffA);
            PG8_BAR; PG8_WAIT_L(0); PG8_MMA(1, 0, At, B0); PG8_BAR; PG8_SCHED;
            PG8_STAGE(PG8_SB(1, 1), b3 + hstep, voffB);
            PG8_WAIT_V(6); PG8_BAR; PG8_MMA(1, 1, At, B1); PG8_BAR;
            }
        }
        if constexpr (ALIGN_EPI) { if (wr == 0) PG8_BAR; }
        if constexpr (!Epi::AFTER_DRAIN) { E(acc, cur, wr, wc, fr, fq); S.done(cur); }
        if (!has_next) break;
#pragma unroll
        for (int a = 0; a < 2; ++a)
#pragma unroll
            for (int b = 0; b < 2; ++b)
#pragma unroll
                for (int m = 0; m < 4; ++m)
#pragma unroll
                    for (int n = 0; n < 2; ++n) acc[a][b][m][n] = (f32x4){0.f, 0.f, 0.f, 0.f};
        cur = nxt; cA = nA; cB = nB; ++ui;
        if constexpr (ALIGN_EPI) { if (wr == 1) PG8_BAR; }
    }
    PG8_WAIT_V(0);
    if constexpr (!ALIGN_EPI) { if (wr == 0) PG8_BAR; }
    PG8_BAR;
    if constexpr (Epi::AFTER_DRAIN) { E.fused(acc, cur, wr, wc, fr, fq, lds, wid, lane); S.done(cur); }
#undef PG8_SA
#undef PG8_SB
#undef PG8_STAGE
#undef PG8_LDA
#undef PG8_LDB
#undef PG8_MMA
#undef PG8_WAIT_V
#undef PG8_WAIT_L
#undef PG8_BAR
#undef PG8_SCHED
}
}
namespace pg8 {
__device__ __forceinline__ float gelu_tanh1(float x) {
    const float z = x * (0.7978845608028654f + 0.035677408136300125f * x * x);
    const float t = __builtin_amdgcn_exp2f(-2.8853900817779268f * z);
    return x * __builtin_amdgcn_rcpf(1.0f + t);
}
constexpr float RMS_EPS = 1e-6f;
struct EpiGateIn {
    static constexpr bool PERM = true, AFTER_DRAIN = false;
    bf16_t* gate; bf16_t* xin; const float* ss;
    __device__ __forceinline__ void operator()(const f32x4 (&acc)[2][2][4][2], const Unit& u, int wr, int wc, int fr, int fq) const {
        const int row0 = u.pm * BM + wr * 64 + fr;
#pragma unroll
        for (int ai = 0; ai < 2; ++ai)
#pragma unroll
            for (int m = 0; m < 4; ++m) {
                const int row = row0 + ai * HALF + m * 16;
                const float rs = __builtin_amdgcn_rsqf(ss[row] * (1.0f / 1024.0f) + RMS_EPS);
#pragma unroll
                for (int bj = 0; bj < 2; ++bj) {
                    const int h128 = u.pn * 2 + bj; const bool isg = h128 < 11;
                    bf16_t* rowp = (isg ? gate : xin) + (size_t)row * 1408 + (isg ? h128 : h128 - 11) * 128 + wc * 32 + 8 * fq;
                    f32x4 v0 = acc[ai][bj][m][0] * rs, v1 = acc[ai][bj][m][1] * rs;
                    if (isg) {
#pragma unroll
                        for (int e = 0; e < 4; ++e) { v0[e] = gelu_tanh1(v0[e]); v1[e] = gelu_tanh1(v1[e]); }
                    }
                    u32x4 w; w.x = cvt_pk_bf16(v0[0], v0[1]); w.y = cvt_pk_bf16(v0[2], v0[3]); w.z = cvt_pk_bf16(v1[0], v1[1]); w.w = cvt_pk_bf16(v1[2], v1[3]);
                    *(u32x4*)rowp = w;
                }
            }
    }
};
struct EpiScaleBf16 {
    static constexpr bool PERM = true, AFTER_DRAIN = false;
    bf16_t* O; int ldc; const float* ss;
    __device__ __forceinline__ void operator()(const f32x4 (&acc)[2][2][4][2], const Unit& u, int wr, int wc, int fr, int fq) const {
        const int row0 = u.pm * BM + wr * 64 + fr, col0 = u.pn * BM + wc * 32 + 8 * fq;
#pragma unroll
        for (int ai = 0; ai < 2; ++ai)
#pragma unroll
            for (int m = 0; m < 4; ++m) {
                const int row = row0 + ai * HALF + m * 16;
                const float rs = __builtin_amdgcn_rsqf(ss[row] * (1.0f / 1024.0f) + RMS_EPS);
                bf16_t* rowp = O + (size_t)row * ldc + col0;
#pragma unroll
                for (int bj = 0; bj < 2; ++bj) {
                    const f32x4 v0 = acc[ai][bj][m][0] * rs, v1 = acc[ai][bj][m][1] * rs;
                    u32x4 w; w.x = cvt_pk_bf16(v0[0], v0[1]); w.y = cvt_pk_bf16(v0[2], v0[3]); w.z = cvt_pk_bf16(v1[0], v1[1]); w.w = cvt_pk_bf16(v1[2], v1[3]);
                    *(u32x4*)(rowp + bj * HALF) = w;
                }
            }
    }
};
struct EpiQKV {
    static constexpr bool PERM = true, AFTER_DRAIN = false;
    bf16_t* q; float* k; float* v; const float* ss;
    __device__ __forceinline__ void operator()(const f32x4 (&acc)[2][2][4][2], const Unit& u, int wr, int wc, int fr, int fq) const {
        const int row0 = u.pm * BM + wr * 64 + fr, cw = wc * 32 + 8 * fq;
#pragma unroll
        for (int ai = 0; ai < 2; ++ai)
#pragma unroll
            for (int m = 0; m < 4; ++m) {
                const int row = row0 + ai * HALF + m * 16;
                const float rs = __builtin_amdgcn_rsqf(ss[row] * (1.0f / 1024.0f) + RMS_EPS);
#pragma unroll
                for (int bj = 0; bj < 2; ++bj) {
                    const f32x4 v0 = acc[ai][bj][m][0] * rs, v1 = acc[ai][bj][m][1] * rs;
                    if (u.pn < 4) {
                        u32x4 w; w.x = cvt_pk_bf16(v0[0], v0[1]); w.y = cvt_pk_bf16(v0[2], v0[3]); w.z = cvt_pk_bf16(v1[0], v1[1]); w.w = cvt_pk_bf16(v1[2], v1[3]);
                        *(u32x4*)(q + (size_t)row * 1024 + u.pn * BM + bj * HALF + cw) = w;
                    } else {
                        float* p = (bj == 0 ? k : v) + (size_t)row * 128 + cw;
                        *(f32x4*)p = v0; *(f32x4*)(p + 4) = v1;
                    }
                }
            }
    }
};
template <bool WITH_HB> struct EpiResid {
    static constexpr bool PERM = false, AFTER_DRAIN = false;
    const float* base; float* out; bf16_t* hb; float* ssq;
    __device__ __forceinline__ void operator()(const f32x4 (&acc)[2][2][4][2], const Unit& u, int wr, int wc, int fr, int fq) const {
        typedef unsigned u32x2v __attribute__((ext_vector_type(2)));
        const int row0 = u.pm * BM + wr * 64 + fr, col0 = u.pn * BM + wc * 32 + 4 * fq;
#pragma unroll
        for (int ai = 0; ai < 2; ++ai)
#pragma unroll
            for (int m = 0; m < 4; ++m) {
                const int row = row0 + ai * HALF + m * 16; const size_t off = (size_t)row * 1024 + col0; float s = 0.f;
#pragma unroll
                for (int bj = 0; bj < 2; ++bj)
#pragma unroll
                    for (int n = 0; n < 2; ++n) {
                        const f32x4 b = *(const f32x4*)(base + off + bj * HALF + n * 16);
                        const f32x4 o = b + acc[ai][bj][m][n];
                        *(f32x4*)(out + off + bj * HALF + n * 16) = o;
                        if (WITH_HB) {
                            s += (o[0] * o[0] + o[1] * o[1]) + (o[2] * o[2] + o[3] * o[3]);
                            u32x2v w; w.x = cvt_pk_bf16(o[0], o[1]); w.y = cvt_pk_bf16(o[2], o[3]);
                            *(u32x2v*)(hb + off + bj * HALF + n * 16) = w;
                        }
                    }
                if (WITH_HB) {
                    s += __shfl_xor(s, 16); s += __shfl_xor(s, 32);
                    if (fq == 0) atomicAdd(ssq + row, s);
                }
            }
    }
};
}
#define GAS __attribute__((address_space(1)))
#define LAS __attribute__((address_space(3)))
typedef unsigned short bf16;
typedef unsigned v4u __attribute__((ext_vector_type(4)));
typedef float f32x4 __attribute__((ext_vector_type(4)));
typedef short bf16x8 __attribute__((ext_vector_type(8)));
typedef GAS unsigned gu32;
typedef GAS unsigned long long gu64;
#define RLX_AGENT __ATOMIC_RELAXED, __HIP_MEMORY_SCOPE_AGENT
#define LDS_WAIT() asm volatile("s_waitcnt lgkmcnt(0)" ::: "memory")
#define VM_WAIT() asm volatile("s_waitcnt vmcnt(0)" ::: "memory")
__device__ __forceinline__ unsigned long long rt() { return __builtin_amdgcn_s_memrealtime(); }
__device__ __forceinline__ unsigned f2bf(float f) { unsigned u = __builtin_bit_cast(unsigned, f); return (u + 0x7fffu + ((u >> 16) & 1u)) >> 16; }
__device__ __forceinline__ unsigned pk2(float lo, float hi) { return f2bf(lo) | (f2bf(hi) << 16); }

#define XB_TMO      128
#define XB_XCNT(j)  (256  + 64 * (j))
#define XB_XSUB(j)  (1280 + 64 * (j))
#define XB_XGEN(j)  (2304 + 64 * (j))
#define XB_TOP      3328
#define XB_TOPGEN   3392
#define XCD_BAR_WORDS 3456
#define XB_SPIN_CAP (1u << 18)

__device__ __forceinline__ unsigned xb_ld(unsigned* p)              { return __hip_atomic_load(p, __ATOMIC_RELAXED, __HIP_MEMORY_SCOPE_AGENT); }
__device__ __forceinline__ unsigned xb_add(unsigned* p, unsigned v) { return __hip_atomic_fetch_add(p, v, __ATOMIC_RELAXED, __HIP_MEMORY_SCOPE_AGENT); }
__device__ __forceinline__ unsigned xb_xcc_id() { return (unsigned)__builtin_amdgcn_s_getreg((3 << 11) | 20) & 0xFu; }
#define XB_SPIN(cond, bar) do { unsigned _sp = 0; while (cond) { __builtin_amdgcn_s_sleep(1); \
    if ((++_sp & 255u) == 0u) { if (xb_ld(&(bar)[XB_TMO])) break; if (_sp > XB_SPIN_CAP) { atomicAdd(&(bar)[XB_TMO], 1u); break; } } } } while (0)

struct XcdBarrier {
    unsigned* bar; unsigned x;
    volatile LAS unsigned* st;
};

__device__ __forceinline__ XcdBarrier xcd_barrier_post(unsigned* bar, volatile LAS unsigned* st, const int tid) {
    XcdBarrier b; b.bar = bar; b.x = xb_xcc_id(); b.st = st;
    if (tid == 0) (void)xb_add(&bar[XB_XCNT(b.x)], 1u);
    return b;
}
__device__ __forceinline__ void xcd_barrier_complete(unsigned* bar, unsigned x, unsigned& nloc, unsigned& nx) {
    const unsigned G = gridDim.x * gridDim.y * gridDim.z;
    unsigned sum, cnt, mine, sp = 0u;
    for (;;) {
        sum = 0u; cnt = 0u; mine = 0u;
#pragma unroll
        for (unsigned j = 0; j < 16; ++j) { const unsigned c = xb_ld(&bar[XB_XCNT(j)]); sum += c; cnt += (c > 0u) ? 1u : 0u; mine = (j == x) ? c : mine; }
        if (sum == G) break;
        __builtin_amdgcn_s_sleep(1);
        if ((++sp & 255u) == 0u) { if (xb_ld(&bar[XB_TMO])) break; if (sp > XB_SPIN_CAP) { atomicAdd(&bar[XB_TMO], 1u); break; } }
    }
    nloc = mine > 0u ? mine : 1u; nx = cnt > 0u ? cnt : 1u;
}

__device__ __forceinline__ void xcd_barrier(const XcdBarrier& b, const int tid) {
    asm volatile("s_waitcnt vmcnt(0)" ::: "memory");
    __syncthreads();
    if (tid == 0) {
        unsigned* bar = b.bar;
        __builtin_amdgcn_s_waitcnt(0);
        unsigned nloc = b.st[0], nx = b.st[1];
        if (nloc == 0u) { xcd_barrier_complete(bar, b.x, nloc, nx); b.st[0] = nloc; b.st[1] = nx; }
        const unsigned old = xb_add(&bar[XB_XSUB(b.x)], 1u);
        const unsigned gen = old / nloc;
        if (old + 1u == (gen + 1u) * nloc) {
            __builtin_amdgcn_fence(__ATOMIC_RELEASE, "agent");
            asm volatile("s_waitcnt vmcnt(0)" ::: "memory");
            const unsigned og = xb_add(&bar[XB_TOP], 1u);
            const unsigned tg = og / nx;
            if (og + 1u == (tg + 1u) * nx) xb_add(&bar[XB_TOPGEN], 1u);
            else XB_SPIN(xb_ld(&bar[XB_TOPGEN]) == tg, bar);
            __builtin_amdgcn_fence(__ATOMIC_ACQUIRE, "agent");
            xb_add(&bar[XB_XGEN(b.x)], 1u);
            asm volatile("s_waitcnt vmcnt(0)" ::: "memory");
        } else {
            XB_SPIN(xb_ld(&bar[XB_XGEN(b.x)]) == gen, bar);
            __builtin_amdgcn_fence(__ATOMIC_ACQUIRE, "agent");
            asm volatile("s_waitcnt vmcnt(0)" ::: "memory");
        }
    }
    __syncthreads();
}
constexpr int BATCH = 16, SEQ = 2048, D = 1024, M = BATCH * SEQ;
constexpr int LW = 1344, LWP = 1408, NBLK = 8, BDIM = 168;
constexpr int FF = 3072, FF2 = 6144, NH = 16, NKV = 2, HD = 64;
constexpr int N1 = 2 * LWP;
constexpr int NQKV = 1280;
enum { I_X = 0, I_POS, I_ANORM, I_WGATE, I_WIN, I_ACONVW, I_ACONVB, I_WRG, I_BRG, I_WIG, I_BIG, I_LAM, I_WOUT, I_KVNORM, I_WK, I_WV, I_KNORM, I_BNORM, I_WQ, I_QNORM, I_SINKS, I_WO, I_FNORM, I_WUP, I_FCONVW, I_FCONVB, I_WDOWN, N_IN };
constexpr size_t MiB = 1u << 20;
constexpr size_t WS_CTL = 0, CTL_ZERO_BYTES = 1 * MiB;
constexpr size_t WS_SSQ = 256 * 1024;
constexpr size_t WS_SS0 = 640 * 1024;
constexpr size_t WS_ROPE = 1 * MiB;
constexpr size_t WS_W1T = 4 * MiB, WS_WOUTT = 10 * MiB, WS_WUPT = 13 * MiB  , WS_WDOWNT = 37 * MiB  , WS_WQKVT = 49 * MiB, WS_WOT = 52 * MiB;
constexpr size_t WS_HB = 64 * MiB;
constexpr size_t WS_GATE = 128 * MiB, WS_XIN = 216 * MiB;
constexpr size_t WS_XR = 304 * MiB;
constexpr size_t WS_ACT = 128 * MiB;
constexpr size_t WS_UPH = 320 * MiB;
constexpr size_t WS_Q = 128 * MiB, WS_AO = 192 * MiB;
constexpr size_t WS_KRAW = 256 * MiB, WS_VRAW = 272 * MiB, WS_KN = 288 * MiB;
constexpr size_t WS_END = 512 * MiB;

__device__ __forceinline__ float bf2f(unsigned short h) { return __builtin_bit_cast(float, (unsigned)h << 16); }
__device__ __forceinline__ float gelu_tanh(float x) { const float z = x * (0.7978845608028654f + 0.035677408136300125f * x * x); return x / (1.0f + __expf(-2.0f * z)); }

constexpr int NWAVES = 8;
constexpr int RING_OFF = 0, RING_BYTES = 131072;
constexpr int LDSCTL_OFF = RING_BYTES, MISC_OFF = LDSCTL_OFF + 320;
constexpr int LDS_BYTES = 147456;
constexpr int NTHR = 512;
struct WtJob { const float* W; int Ksrc, Nsrc, ld; const float* g; bf16* Wt; int Nout, Kout, mode; };
__device__ __forceinline__ void p_wt(const WtJob& J, LAS unsigned char* lds, const int tid) {
    const int half = tid >> 8, t = tid & 255, tx = t & 31, ty = t >> 5;
    LAS float* tile = (LAS float*)(lds + half * 4352);
    const int nkt = J.Kout / 32, ntile = nkt * (J.Nout / 32);
    for (int it = blockIdx.x * 2; it < ntile; it += gridDim.x * 2) {
        const int tl = it + half, k0 = (tl % nkt) * 32, n0 = (tl / nkt) * 32;
#pragma unroll
        for (int j = 0; j < 4; ++j) {
            const int k = k0 + ty + 8 * j, n = n0 + tx;
            const int ns = J.mode == 2 ? (((n & 255) >> 7) ? 3072 : 0) + 128 * (n >> 8) + (n & 127) : n;
            float v = 0.f;
            if (k < J.Ksrc && ns < J.Nsrc) v = J.W[(size_t)k * J.ld + ns] * (J.g ? J.g[k] : 1.0f);
            tile[(ty + 8 * j) * 33 + tx] = v;
        }
        __syncthreads();
#pragma unroll
        for (int j = 0; j < 4; ++j) {
            const int n = n0 + ty + 8 * j, k = k0 + tx;
            J.Wt[(size_t)n * J.Kout + k] = (bf16)f2bf(tile[tx * 33 + ty + 8 * j]);
        }
        __syncthreads();
    }
}
__device__ __forceinline__ void p_xprep(const float* __restrict__ x, bf16* __restrict__ xb, float* __restrict__ ss0, const int tid) {
    const int lane = tid & 63;
    for (int row = blockIdx.x * NWAVES + (tid >> 6); row < M; row += gridDim.x * NWAVES) {
        const f32x4* xr = (const f32x4*)(x + (size_t)row * D) + lane;
        unsigned long long* o8 = (unsigned long long*)(xb + (size_t)row * D) + lane;
        float s = 0.f;
#pragma unroll
        for (int j = 0; j < 4; ++j) {
            const f32x4 v = xr[64 * j]; s += (v.x * v.x + v.y * v.y) + (v.z * v.z + v.w * v.w);
            o8[64 * j] = (unsigned long long)pk2(v.x, v.y) | ((unsigned long long)pk2(v.z, v.w) << 32);
        }
#pragma unroll
        for (int o = 1; o < 64; o <<= 1) s += __shfl_xor(s, o);
        if (lane == 0) ss0[row] = s;
    }
}
struct RopeFreq { float f[8]; };
__device__ __forceinline__ void p_rope(const int* __restrict__ pos, float* __restrict__ cs, const RopeFreq& rf, const int tid) {
    for (int idx = blockIdx.x * NTHR + tid; idx < M * 8; idx += gridDim.x * NTHR) {
        const int m = idx >> 3, i = idx & 7;
        const float ang = (float)pos[m] * rf.f[i];
        cs[(size_t)idx * 2] = cosf(ang); cs[(size_t)idx * 2 + 1] = sinf(ang);
    }
}
__device__ __forceinline__ void p_convffn(const bf16* __restrict__ uph, const float* __restrict__ cw, const float* __restrict__ cb, bf16* __restrict__ act, int mbase, const int tid) {
    for (size_t idx = (size_t)blockIdx.x * NTHR + tid; idx < (size_t)(M / 2) * FF; idx += (size_t)gridDim.x * NTHR) {
        const int mh = (int)(idx / FF), c = (int)(idx % FF), m = mbase + mh, t = m % SEQ;
        const int ng = (c >> 7) * 256 + (c & 127), nv = ng + 128;
        float g = cb[c], v = cb[FF + c];
#pragma unroll
        for (int k = 0; k < 3; ++k) if (t - 2 + k >= 0) { const size_t r = (size_t)(mh - 2 + k) * FF2; g += bf2f(uph[r + ng]) * cw[k * FF2 + c]; v += bf2f(uph[r + nv]) * cw[k * FF2 + FF + c]; }
        act[(size_t)m * FF + c] = (bf16)f2bf(gelu_tanh(g) * v);
    }
}
constexpr int SC_T = 64, SC_AP = 416;
constexpr int SC_A = 0, SC_XRO = SC_A + SC_T * SC_AP, SC_AB = SC_XRO + SC_T * 168 * 4, SC_UB = SC_AB + SC_T * 96 * 4, SC_SEG = SC_UB + SC_T * 96 * 4, SC_CARRY = SC_SEG + 4 * 96 * 2 * 4, SC_END = SC_CARRY + 2 * 96 * 4;
static_assert(SC_END <= RING_BYTES, "scan phase LDS");
__device__ __forceinline__ void p_scan_fast(const bf16* __restrict__ xin, bf16* gate, const float* __restrict__ cw, const float* __restrict__ cb, const float* __restrict__ wrg, const float* __restrict__ brg,
                                            const float* __restrict__ wig, const float* __restrict__ big, const float* __restrict__ lam, LAS unsigned char* lds, const int tid) {
    const int lane = tid & 63, wid = __builtin_amdgcn_readfirstlane(tid >> 6);
    constexpr float LOG2E = 1.4426950408889634f;
    const int unit = blockIdx.x;
    if (unit < BATCH * NBLK * 2) {
        const int b = unit >> 4, hb = (unit >> 1) & 7, half = unit & 1;
        const int cbase = hb * BDIM, own0 = cbase + half * 84;
        for (int i = tid; i < SC_T * 12; i += NTHR) ((LAS unsigned*)(lds + SC_A + (i / 12) * SC_AP + 336))[i % 12] = 0u;
        if (tid < 96) ((LAS float*)(lds + SC_CARRY))[tid] = 0.f;
        const int o = tid % 21, s = tid / 21;
        float w1[4][8], cbv[8];
#pragma unroll
        for (int e = 0; e < 8; ++e) { cbv[e] = cb[cbase + o * 8 + e];
#pragma unroll
            for (int k = 0; k < 4; ++k) w1[k][e] = cw[k * LW + cbase + o * 8 + e]; }
        const int n = lane & 15, q = lane >> 4, j2 = wid * 16 + n; const bool v2 = (wid < 6) && (j2 < 84);
        pg8::bf16x8 Br[6], Bi[6];
#pragma unroll
        for (int ks = 0; ks < 6; ++ks) {
#pragma unroll
            for (int e = 0; e < 8; ++e) {
                const int k = ks * 32 + q * 8 + e; float a = 0.f, c = 0.f;
                const bool kok = v2 && (ks < 5 || q == 0);
                { const size_t off = ((size_t)(hb * BDIM + (kok ? k : 0))) * BDIM + half * 84 + (v2 ? j2 : 0); a = kok ? wrg[off] : 0.f; c = kok ? wig[off] : 0.f; }
                Br[ks][e] = (short)f2bf(a); Bi[ks][e] = (short)f2bf(c);
            }
            __builtin_amdgcn_sched_barrier(0);
        }
        float br2 = 0.f, bi2 = 0.f, lac = 0.f;
        if (v2) { br2 = brg[own0 + j2]; bi2 = big[own0 + j2]; const float lm = lam[own0 + j2]; lac = -8.0f * ((lm < 0.f ? -lm : 0.f) + log1pf(expf(-fabsf(lm)))); }
        const int seg = tid / 96, ch = tid % 96; const bool v3 = (tid < 384) && (ch < 84);
        LAS float* XRO = (LAS float*)(lds + SC_XRO); LAS float* AB = (LAS float*)(lds + SC_AB); LAS float* UB = (LAS float*)(lds + SC_UB);
        LAS float* SEGB = (LAS float*)(lds + SC_SEG); LAS float* CARRY = (LAS float*)(lds + SC_CARRY);
        for (int ck = 0; ck < SEQ / SC_T; ++ck) {
            const int t0 = ck * SC_T;
            if (tid < 504) {
#pragma unroll
                for (int r = 0; r < 3; ++r) {
                    const int tok = s + 24 * r;
                    if (tok < SC_T) {
                        const int t = t0 + tok; const size_t m = (size_t)b * SEQ + t;
                        float acc[8];
#pragma unroll
                        for (int e = 0; e < 8; ++e) acc[e] = cbv[e];
#pragma unroll
                        for (int k = 0; k < 4; ++k) {
                            {
                                const bool tok_ok = t - 3 + k >= 0;
                                v4u v = *(const v4u*)(xin + (tok_ok ? m - 3 + k : m) * LWP + cbase + o * 8);
                                if (!tok_ok) v = (v4u){0u, 0u, 0u, 0u};
                                acc[0] += w1[k][0] * __builtin_bit_cast(float, v.x << 16); acc[1] += w1[k][1] * __builtin_bit_cast(float, v.x & 0xffff0000u);
                                acc[2] += w1[k][2] * __builtin_bit_cast(float, v.y << 16); acc[3] += w1[k][3] * __builtin_bit_cast(float, v.y & 0xffff0000u);
                                acc[4] += w1[k][4] * __builtin_bit_cast(float, v.z << 16); acc[5] += w1[k][5] * __builtin_bit_cast(float, v.z & 0xffff0000u);
                                acc[6] += w1[k][6] * __builtin_bit_cast(float, v.w << 16); acc[7] += w1[k][7] * __builtin_bit_cast(float, v.w & 0xffff0000u);
                            }
                        }
                        v4u pk; pk.x = pk2(acc[0], acc[1]); pk.y = pk2(acc[2], acc[3]); pk.z = pk2(acc[4], acc[5]); pk.w = pk2(acc[6], acc[7]);
                        *(LAS v4u*)(lds + SC_A + tok * SC_AP + o * 16) = pk;
                        *(LAS f32x4*)(XRO + tok * 168 + o * 8) = (f32x4){acc[0], acc[1], acc[2], acc[3]}; *(LAS f32x4*)(XRO + tok * 168 + o * 8 + 4) = (f32x4){acc[4], acc[5], acc[6], acc[7]};
                    }
                }
            }
            __syncthreads();
            if (wid < 6) {
#pragma unroll
                for (int tt = 0; tt < 4; ++tt) {
                    f32x4 ar = {0.f, 0.f, 0.f, 0.f}, ai = {0.f, 0.f, 0.f, 0.f};
#pragma unroll
                    for (int ks = 0; ks < 6; ++ks) {
                        const pg8::bf16x8 af = *(const LAS pg8::bf16x8*)(lds + SC_A + (tt * 16 + n) * SC_AP + ks * 64 + q * 16);
                        ar = __builtin_amdgcn_mfma_f32_16x16x32_bf16(af, Br[ks], ar, 0, 0, 0);
                        ai = __builtin_amdgcn_mfma_f32_16x16x32_bf16(af, Bi[ks], ai, 0, 0, 0);
                    }
#pragma unroll
                    for (int rg = 0; rg < 4; ++rg) {
                        const int tok = tt * 16 + q * 4 + rg;
                        const float zr = ar[rg] + br2, zi = ai[rg] + bi2;
                        const float r = __builtin_amdgcn_rcpf(1.0f + __builtin_amdgcn_exp2f(-LOG2E * zr)), ig = __builtin_amdgcn_rcpf(1.0f + __builtin_amdgcn_exp2f(-LOG2E * zi));
                        const float la = r * lac, a = __builtin_amdgcn_exp2f(LOG2E * la), x2 = 2.0f * la;
                        const float m2s = -(x2 * (1.0f + x2 * (0.5f + x2 * (0.16666667f + x2 * (0.041666668f + x2 * 0.008333334f)))));
                        const float m2 = x2 > -0.25f ? m2s : 1.0f - a * a;
                        const float mult = __builtin_amdgcn_sqrtf(m2);
                        const float xv = XRO[tok * 168 + half * 84 + (v2 ? j2 : 0)];
                        AB[tok * 96 + j2] = a; UB[tok * 96 + j2] = v2 ? mult * ig * xv : 0.f;
                    }
                }
            }
            __syncthreads();
            float hl[16], pl[16];
            if (tid < 384) {
                float h = 0.f, P = 1.f;
#pragma unroll
                for (int k = 0; k < 16; ++k) { const int tok = seg * 16 + k; const float a = AB[tok * 96 + ch], u = UB[tok * 96 + ch]; h = a * h + u; P *= a; hl[k] = h; pl[k] = P; }
                SEGB[(seg * 96 + ch) * 2] = P; SEGB[(seg * 96 + ch) * 2 + 1] = h;
            }
            __syncthreads();
            if (tid < 384) {
                float c = CARRY[(ck & 1) * 96 + ch];
                if (seg > 0) c = SEGB[(0 * 96 + ch) * 2] * c + SEGB[(0 * 96 + ch) * 2 + 1];
                if (seg > 1) c = SEGB[(1 * 96 + ch) * 2] * c + SEGB[(1 * 96 + ch) * 2 + 1];
                if (seg > 2) c = SEGB[(2 * 96 + ch) * 2] * c + SEGB[(2 * 96 + ch) * 2 + 1];
                if (seg == 3) CARRY[((ck + 1) & 1) * 96 + ch] = pl[15] * c + hl[15];
                if (v3) {
                    bf16* gp = gate + ((size_t)b * SEQ + t0 + seg * 16) * LWP + own0 + ch;
#pragma unroll
                    for (int k = 0; k < 16; ++k) { const float y = bf2f(gp[(size_t)k * LWP]) * (hl[k] + pl[k] * c); gp[(size_t)k * LWP] = (bf16)f2bf(y); }
                }
            }
        }
        __syncthreads();
    }
}
constexpr int AT_KP = 144, AT_VP = 392;
constexpr int AT_K = 0, AT_V = AT_K + 192 * AT_KP, AT_O = AT_V + 64 * AT_VP, AT_END = AT_O + 8 * 4096;
static_assert(AT_END <= RING_BYTES && AT_V % 16 == 0 && AT_O % 16 == 0, "attention phase LDS");
typedef float f32x16 __attribute__((ext_vector_type(16)));
__device__ __forceinline__ void p_attn_fast(const bf16* __restrict__ q, const float* __restrict__ kraw, const float* __restrict__ vraw, const float* __restrict__ knorm, const float* __restrict__ qnorm,
                                            const float* __restrict__ sinks, const float* __restrict__ cs, bf16* __restrict__ ao, LAS unsigned char* lds, const int tid) {
    const int lane = tid & 63, wid = __builtin_amdgcn_readfirstlane(tid >> 6), qq = lane & 31, hh = lane >> 5;
    constexpr float LOG2E = 1.4426950408889634f;
    const int c8 = tid & 7, rsub = tid >> 3;
    float kg[8];
#pragma unroll
    for (int e = 0; e < 8; ++e) kg[e] = knorm[c8 * 8 + e];
    for (int unit = blockIdx.x; unit < BATCH * NKV * (SEQ / 64); unit += gridDim.x) {
        const int b = unit >> 6, kvh = (unit >> 5) & 1, r0 = (unit & 31) * 64, h = kvh * 8 + wid;
        const size_t mb = (size_t)b * SEQ;
        __syncthreads();
#pragma unroll
        for (int ps = 0; ps < 3; ++ps) {
            const int kk = ps * 64 + rsub, t = r0 - 128 + kk;
            v4u kp = {0u, 0u, 0u, 0u}; float vv[8];
#pragma unroll
            for (int e = 0; e < 8; ++e) vv[e] = 0.f;
            if (t >= 0) {
                const f32x4 a0 = *(const f32x4*)(kraw + (mb + t) * 128 + kvh * 64 + c8 * 8), a1 = *(const f32x4*)(kraw + (mb + t) * 128 + kvh * 64 + c8 * 8 + 4);
                const f32x4 b0 = *(const f32x4*)(vraw + (mb + t) * 128 + kvh * 64 + c8 * 8), b1 = *(const f32x4*)(vraw + (mb + t) * 128 + kvh * 64 + c8 * 8 + 4);
                float kx[8] = {a0[0], a0[1], a0[2], a0[3], a1[0], a1[1], a1[2], a1[3]};
                vv[0] = b0[0]; vv[1] = b0[1]; vv[2] = b0[2]; vv[3] = b0[3]; vv[4] = b1[0]; vv[5] = b1[1]; vv[6] = b1[2]; vv[7] = b1[3];
                float ss = 0.f;
#pragma unroll
                for (int e = 0; e < 8; ++e) ss += kx[e] * kx[e];
                ss += __shfl_xor(ss, 1); ss += __shfl_xor(ss, 2); ss += __shfl_xor(ss, 4);
                const float rs = rsqrtf(ss * (1.0f / 64.0f) + 1e-6f);
#pragma unroll
                for (int e = 0; e < 8; ++e) kx[e] = kx[e] * rs * kg[e];
                float px[8];
#pragma unroll
                for (int e = 0; e < 8; ++e) px[e] = __shfl_xor(kx[e], 1);
                if (c8 < 2) {
                    const float* cp = cs + (mb + t) * 16;
#pragma unroll
                    for (int e = 0; e < 8; ++e) { const float c = cp[2 * e], sn = cp[2 * e + 1]; kx[e] = c8 == 0 ? kx[e] * c - px[e] * sn : kx[e] * c + px[e] * sn; }
                }
                kp.x = pk2(kx[0], kx[1]); kp.y = pk2(kx[2], kx[3]); kp.z = pk2(kx[4], kx[5]); kp.w = pk2(kx[6], kx[7]);
            }
            *(LAS v4u*)(lds + AT_K + kk * AT_KP + c8 * 16) = kp;
#pragma unroll
            for (int e = 0; e < 8; ++e) *(LAS unsigned short*)(lds + AT_V + (c8 * 8 + e) * AT_VP + kk * 2) = (unsigned short)f2bf(vv[e]);
        }
        __syncthreads();
        const float sink2 = sinks[h] * LOG2E;
#pragma unroll 1
        for (int sb = 0; sb < 2; ++sb) {
            const int rq = r0 + sb * 32;
            float qf[4][8]; float ss = 0.f;
#pragma unroll
            for (int ks = 0; ks < 4; ++ks) {
                const v4u v = *(const v4u*)(q + (mb + rq + qq) * 1024 + h * 64 + ks * 16 + hh * 8);
                qf[ks][0] = __builtin_bit_cast(float, v.x << 16); qf[ks][1] = __builtin_bit_cast(float, v.x & 0xffff0000u); qf[ks][2] = __builtin_bit_cast(float, v.y << 16); qf[ks][3] = __builtin_bit_cast(float, v.y & 0xffff0000u);
                qf[ks][4] = __builtin_bit_cast(float, v.z << 16); qf[ks][5] = __builtin_bit_cast(float, v.z & 0xffff0000u); qf[ks][6] = __builtin_bit_cast(float, v.w << 16); qf[ks][7] = __builtin_bit_cast(float, v.w & 0xffff0000u);
#pragma unroll
                for (int e = 0; e < 8; ++e) ss += qf[ks][e] * qf[ks][e];
            }
            ss += __shfl_xor(ss, 32);
            const float rs = rsqrtf(ss * (1.0f / 64.0f) + 1e-6f) * (0.125f * LOG2E);
#pragma unroll
            for (int ks = 0; ks < 4; ++ks)
#pragma unroll
                for (int e = 0; e < 8; ++e) qf[ks][e] = qf[ks][e] * rs * qnorm[ks * 16 + hh * 8 + e];
            {
                const float* cp = cs + (mb + rq + qq) * 16;
#pragma unroll
                for (int e = 0; e < 8; ++e) { const float px = __shfl_xor(qf[0][e], 32); const float c = cp[2 * e], sn = cp[2 * e + 1]; qf[0][e] = hh == 0 ? qf[0][e] * c - px * sn : qf[0][e] * c + px * sn; }
            }
            pg8::bf16x8 qb[4];
#pragma unroll
            for (int ks = 0; ks < 4; ++ks) { v4u w; w.x = pk2(qf[ks][0], qf[ks][1]); w.y = pk2(qf[ks][2], qf[ks][3]); w.z = pk2(qf[ks][4], qf[ks][5]); w.w = pk2(qf[ks][6], qf[ks][7]); qb[ks] = __builtin_bit_cast(pg8::bf16x8, w); }
            const int ktmin = (128 - rq) > 0 ? (128 - rq) / 32 : 0;
            f32x16 p[5];
#pragma unroll
            for (int kt = 0; kt < 5; ++kt) {
                f32x16 acc;
#pragma unroll
                for (int r = 0; r < 16; ++r) acc[r] = 0.f;
                if (kt >= ktmin) {
#pragma unroll
                    for (int ks = 0; ks < 4; ++ks) {
                        const pg8::bf16x8 kf = *(const LAS pg8::bf16x8*)(lds + AT_K + ((sb + kt) * 32 + qq) * AT_KP + ks * 32 + hh * 16);
                        acc = __builtin_amdgcn_mfma_f32_32x32x16_bf16(kf, qb[ks], acc, 0, 0, 0);
                    }
                }
#pragma unroll
                for (int r = 0; r < 16; ++r) {
                    const int cr = (r & 3) + 8 * (r >> 2) + 4 * hh;
                    bool ok = kt >= ktmin;
                    if (kt == 0) ok = ok && (cr > qq);
                    if (kt == 4) ok = ok && (cr <= qq);
                    p[kt][r] = ok ? acc[r] : -INFINITY;
                }
            }
            float mx = sink2;
#pragma unroll
            for (int kt = 0; kt < 5; ++kt)
#pragma unroll
                for (int r = 0; r < 16; ++r) mx = fmaxf(mx, p[kt][r]);
            mx = fmaxf(mx, __shfl_xor(mx, 32));
            float l = 0.f;
#pragma unroll
            for (int kt = 0; kt < 5; ++kt)
#pragma unroll
                for (int r = 0; r < 16; ++r) { p[kt][r] = __builtin_amdgcn_exp2f(p[kt][r] - mx); l += p[kt][r]; }
            l += __shfl_xor(l, 32);
            l += __builtin_amdgcn_exp2f(sink2 - mx);
            const float il = 1.0f / l;
            f32x16 o0, o1;
#pragma unroll
            for (int r = 0; r < 16; ++r) { o0[r] = 0.f; o1[r] = 0.f; }
#pragma unroll
            for (int kt = 0; kt < 5; ++kt) {
                if (kt >= ktmin) {
#pragma unroll
                    for (int s = 0; s < 2; ++s) {
                        v4u w; w.x = pk2(p[kt][8 * s + 0] * il, p[kt][8 * s + 1] * il); w.y = pk2(p[kt][8 * s + 2] * il, p[kt][8 * s + 3] * il);
                        w.z = pk2(p[kt][8 * s + 4] * il, p[kt][8 * s + 5] * il); w.w = pk2(p[kt][8 * s + 6] * il, p[kt][8 * s + 7] * il);
                        const pg8::bf16x8 pa = __builtin_bit_cast(pg8::bf16x8, w);
                        const int kb = ((sb + kt) * 32 + 16 * s + 4 * hh) * 2;
                        typedef unsigned u32x2v __attribute__((ext_vector_type(2)));
                        const u32x2v v00 = *(const LAS u32x2v*)(lds + AT_V + qq * AT_VP + kb), v01 = *(const LAS u32x2v*)(lds + AT_V + qq * AT_VP + kb + 16);
                        const u32x2v v10 = *(const LAS u32x2v*)(lds + AT_V + (32 + qq) * AT_VP + kb), v11 = *(const LAS u32x2v*)(lds + AT_V + (32 + qq) * AT_VP + kb + 16);
                        const v4u vb0 = {v00.x, v00.y, v01.x, v01.y}, vb1 = {v10.x, v10.y, v11.x, v11.y};
                        o0 = __builtin_amdgcn_mfma_f32_32x32x16_bf16(pa, __builtin_bit_cast(pg8::bf16x8, vb0), o0, 0, 0, 0);
                        o1 = __builtin_amdgcn_mfma_f32_32x32x16_bf16(pa, __builtin_bit_cast(pg8::bf16x8, vb1), o1, 0, 0, 0);
                    }
                }
            }
            LAS unsigned short* stg = (LAS unsigned short*)(lds + AT_O + wid * 4096);
#pragma unroll
            for (int r = 0; r < 16; ++r) { const int orow = (r & 3) + 8 * (r >> 2) + 4 * hh; stg[orow * 64 + qq] = (unsigned short)f2bf(o0[r]); stg[orow * 64 + 32 + qq] = (unsigned short)f2bf(o1[r]); }
            asm volatile("s_waitcnt lgkmcnt(0)" ::: "memory");
#pragma unroll
            for (int i = 0; i < 4; ++i) { const int row = i * 8 + (lane >> 3), ch = lane & 7; const v4u v = *(const LAS v4u*)(stg + row * 64 + ch * 8); *(v4u*)(ao + (mb + rq + row) * 1024 + h * 64 + ch * 8) = v; }
            asm volatile("s_waitcnt lgkmcnt(0)" ::: "memory");
        }
    }
}
constexpr int CW_BAR = 4096;
struct Args { const void* in[N_IN]; float* out; unsigned char* ws; RopeFreq rf; };

__global__ void __launch_bounds__(NWAVES * 64, 2) skel_fwd(Args args) {
    extern __shared__ __attribute__((aligned(16))) unsigned char lds[];
    LAS unsigned char* L = (LAS unsigned char*)lds;
    volatile LAS unsigned* MISC = (volatile LAS unsigned*)(L + MISC_OFF);
    unsigned char* ws = args.ws;
    const int G = gridDim.x;
    const int wid_s = __builtin_amdgcn_readfirstlane((int)threadIdx.x >> 6);
#define TID() pg8_fresh_tid(wid_s)
    for (int u = TID(); u < (LDS_BYTES - LDSCTL_OFF) / 4; u += NWAVES * 64) ((LAS unsigned*)(L + LDSCTL_OFF))[u] = 0u;
    __syncthreads();
    XcdBarrier bar = xcd_barrier_post((unsigned*)(ws + WS_CTL) + CW_BAR, MISC + 8, TID());
#define GRID_BAR() xcd_barrier(bar, TID())
#define FIN(i) ((const float*)args.in[i])
    const float* x = FIN(I_X);
    float* ssq = (float*)(ws + WS_SSQ);
    float* ss0 = (float*)(ws + WS_SS0);
    bf16* HB = (bf16*)(ws + WS_HB);
    const float* cs = (const float*)(ws + WS_ROPE);

    {
        const int ptid = TID();
        { WtJob J{FIN(I_WGATE), D, LW, LW, FIN(I_ANORM), (bf16*)(ws + WS_W1T), LWP, D, 0}; p_wt(J, L, ptid); }
        { WtJob J{FIN(I_WIN), D, LW, LW, FIN(I_ANORM), (bf16*)(ws + WS_W1T) + (size_t)LWP * D, LWP, D, 0}; p_wt(J, L, ptid); }
        { WtJob J{FIN(I_WOUT), LW, D, D, nullptr, (bf16*)(ws + WS_WOUTT), D, LWP, 0}; p_wt(J, L, ptid); }
#pragma unroll
        for (int l = 0; l < 2; ++l) {
            { WtJob J{FIN(I_WUP) + (size_t)l * D * FF2, D, FF2, FF2, FIN(I_FNORM) + l * D, (bf16*)(ws + WS_WUPT) + (size_t)l * FF2 * D, FF2, D, 2}; p_wt(J, L, ptid); }
            { WtJob J{FIN(I_WDOWN) + (size_t)l * FF * D, FF, D, D, nullptr, (bf16*)(ws + WS_WDOWNT) + (size_t)l * D * FF, D, FF, 0}; p_wt(J, L, ptid); }
        }
        { WtJob J{FIN(I_WQ), D, 1024, 1024, FIN(I_BNORM), (bf16*)(ws + WS_WQKVT), 1024, D, 0}; p_wt(J, L, ptid); }
        { WtJob J{FIN(I_WK), D, 128, 128, FIN(I_KVNORM), (bf16*)(ws + WS_WQKVT) + (size_t)1024 * D, 128, D, 0}; p_wt(J, L, ptid); }
        { WtJob J{FIN(I_WV), D, 128, 128, FIN(I_KVNORM), (bf16*)(ws + WS_WQKVT) + (size_t)1152 * D, 128, D, 0}; p_wt(J, L, ptid); }
        { WtJob J{FIN(I_WO), D, D, D, nullptr, (bf16*)(ws + WS_WOT), D, D, 0}; p_wt(J, L, ptid); }
        p_xprep(x, HB, ss0, ptid);
        p_rope((const int*)args.in[I_POS], (float*)(ws + WS_ROPE), args.rf, ptid);
    }
    GRID_BAR();
    {
        pg8::Gemm g{HB, (const bf16*)(ws + WS_W1T), M, N1, D}; pg8::StaticOrder S; S.init(M, N1, G, (int)blockIdx.x);
        pg8::EpiGateIn E{(bf16*)(ws + WS_GATE), (bf16*)(ws + WS_XIN), ss0};
        pg8::gemm_phase<pg8::EpiGateIn, pg8::StaticOrder, true, true>(L + RING_OFF, g, S, E, wid_s);
    }
    GRID_BAR();
    p_scan_fast((const bf16*)(ws + WS_XIN), (bf16*)(ws + WS_GATE), FIN(I_ACONVW), FIN(I_ACONVB), FIN(I_WRG), FIN(I_BRG), FIN(I_WIG), FIN(I_BIG), FIN(I_LAM), L + RING_OFF, TID());
    GRID_BAR();
    {
        pg8::Gemm g{(const bf16*)(ws + WS_GATE), (const bf16*)(ws + WS_WOUTT), M, D, LWP}; pg8::StaticOrder S; S.init(M, D, G, (int)blockIdx.x);
        pg8::EpiResid<true> E{x, args.out, HB, ssq};
        pg8::gemm_phase<pg8::EpiResid<true>, pg8::StaticOrder, true, true>(L + RING_OFF, g, S, E, wid_s);
    }
    GRID_BAR();
#define FFN_UP_HALF(l, half) do { \
        { pg8::Gemm g{HB + (size_t)(half) * (M / 2) * D, (const bf16*)(ws + WS_WUPT) + (size_t)(l) * FF2 * D, M / 2, FF2, D}; pg8::StaticOrder S; S.init(M / 2, FF2, G, (int)blockIdx.x); \
          pg8::EpiScaleBf16 E{(bf16*)(ws + WS_UPH), FF2, ssq + (size_t)((l) == 0 ? 0 : 2) * M + (size_t)(half) * (M / 2)}; \
          pg8::gemm_phase<pg8::EpiScaleBf16, pg8::StaticOrder, true, true>(L + RING_OFF, g, S, E, wid_s); } \
        GRID_BAR(); \
        p_convffn((const bf16*)(ws + WS_UPH), FIN(I_FCONVW) + (size_t)(l) * 3 * FF2, FIN(I_FCONVB) + (size_t)(l) * FF2, (bf16*)(ws + WS_ACT), (half) * (M / 2), TID()); \
        GRID_BAR(); } while (0)
    FFN_UP_HALF(0, 0); FFN_UP_HALF(0, 1);
    {
        pg8::Gemm g{(const bf16*)(ws + WS_ACT), (const bf16*)(ws + WS_WDOWNT), M, D, FF}; pg8::StaticOrder S; S.init(M, D, G, (int)blockIdx.x);
        pg8::EpiResid<true> E{args.out, args.out, HB, ssq + M};
        pg8::gemm_phase<pg8::EpiResid<true>, pg8::StaticOrder, true, true>(L + RING_OFF, g, S, E, wid_s);
    }
    GRID_BAR();
    {
        pg8::Gemm g{HB, (const bf16*)(ws + WS_WQKVT), M, NQKV, D}; pg8::StaticOrder S; S.init(M, NQKV, G, (int)blockIdx.x);
        pg8::EpiQKV E{(bf16*)(ws + WS_Q), (float*)(ws + WS_KRAW), (float*)(ws + WS_VRAW), ssq + M};
        pg8::gemm_phase<pg8::EpiQKV, pg8::StaticOrder, true, true>(L + RING_OFF, g, S, E, wid_s);
    }
    GRID_BAR();
    p_attn_fast((const bf16*)(ws + WS_Q), (const float*)(ws + WS_KRAW), (const float*)(ws + WS_VRAW), FIN(I_KNORM), FIN(I_QNORM), FIN(I_SINKS), cs, (bf16*)(ws + WS_AO), L + RING_OFF, TID());
    GRID_BAR();
    {
        pg8::Gemm g{(const bf16*)(ws + WS_AO), (const bf16*)(ws + WS_WOT), M, D, D}; pg8::StaticOrder S; S.init(M, D, G, (int)blockIdx.x);
        pg8::EpiResid<true> E{args.out, args.out, HB, ssq + 2 * (size_t)M};
        pg8::gemm_phase<pg8::EpiResid<true>, pg8::StaticOrder, true, true>(L + RING_OFF, g, S, E, wid_s);
    }
    GRID_BAR();
    FFN_UP_HALF(1, 0); FFN_UP_HALF(1, 1);
    {
        pg8::Gemm g{(const bf16*)(ws + WS_ACT), (const bf16*)(ws + WS_WDOWNT) + (size_t)D * FF, M, D, FF}; pg8::StaticOrder S; S.init(M, D, G, (int)blockIdx.x);
        pg8::EpiResid<false> E{args.out, args.out, nullptr, nullptr};
        pg8::gemm_phase<pg8::EpiResid<false>, pg8::StaticOrder, true, true>(L + RING_OFF, g, S, E, wid_s);
    }
#undef FFN_UP_HALF
#undef GRID_BAR
#undef FIN
}

extern "C" void kernel_launch(void* const* d_in, const int* in_sizes, int n_in, void* d_out, int out_size, void* d_ws, size_t ws_size, hipStream_t stream) {
    static int grid = 0;
    if (grid == 0) {
        if (n_in != N_IN || in_sizes[0] != M * D || out_size != M * D || ws_size < WS_END) { fprintf(stderr, "kernel_launch: shape/workspace mismatch (n_in %d, in0 %d, out %d, ws %zu)\n", n_in, n_in > 0 ? in_sizes[0] : -1, out_size, ws_size); grid = -1; return; }
        int dev = 0, cus = 0, per_cu = 0;
        if (hipGetDevice(&dev) != hipSuccess || hipDeviceGetAttribute(&cus, hipDeviceAttributeMultiprocessorCount, dev) != hipSuccess) { grid = -1; return; }
        if (hipFuncSetAttribute((const void*)skel_fwd, hipFuncAttributeMaxDynamicSharedMemorySize, LDS_BYTES) != hipSuccess) { fprintf(stderr, "kernel_launch: hipFuncSetAttribute failed\n"); grid = -1; return; }
        if (hipOccupancyMaxActiveBlocksPerMultiprocessor(&per_cu, (const void*)skel_fwd, NWAVES * 64, LDS_BYTES) != hipSuccess || per_cu < 1)
            fprintf(stderr, "kernel_launch: note: occupancy query reports %d workgroups per CU\n", per_cu);
        (void)hipGetLastError();
        grid = cus;
    }
    if (grid < 0) return;
    unsigned char* ws = (unsigned char*)d_ws;
    (void)hipMemsetAsync(ws + WS_CTL, 0, CTL_ZERO_BYTES, stream);
    Args a{};
    for (int i = 0; i < N_IN; ++i) a.in[i] = d_in[i];
    a.out = (float*)d_out; a.ws = ws;
    for (int i = 0; i < 8; ++i) a.rf.f[i] = (float)pow(500000.0, -(double)i / 8.0);
    hipLaunchKernelGGL(skel_fwd, dim3(grid), dim3(NWAVES * 64), LDS_BYTES, stream, a);
}
```
